# Optimizing an MI355X kernel written in HIP

```python
import jax
import jax.numpy as jnp
from jax import lax
import numpy as np

D_MODEL = 4096
BATCH = 4
SEQ = 2048
DEPTH = 1

CHUNK = 64
EPS = 1e-6
FFN_RES = 0.5
D_FF = 11008
D_CONV = 2048
CONV_W = 3
GLA_HEADS = 4
D_GLA_K = 1024
D_GLA_V = 2048
HEAD_K = D_GLA_K // GLA_HEADS
HEAD_V = D_GLA_V // GLA_HEADS
GATE_RANK = 16
GATE_TEMP = 16.0
N_BRANCH = 2
IN_SPLIT_SIZES = (D_CONV, D_CONV, D_CONV, D_GLA_K, D_GLA_K, D_GLA_V, D_GLA_V, GATE_RANK, D_MODEL, D_MODEL)
D_IN = 3 * D_CONV + 2 * D_GLA_K + 2 * D_GLA_V + GATE_RANK + N_BRANCH * D_MODEL

kernel_name = "hybrid_shortconv_gla_macaron_block"


def _rmsnorm(x, g):
    xf = x.astype(jnp.float32)
    y = xf * lax.rsqrt(jnp.mean(xf * xf, axis=-1, keepdims=True) + EPS)
    return (y * g.astype(jnp.float32)).astype(x.dtype)


def _swiglu(h, w_gate, w_up, w_down):
    return (jax.nn.silu(h @ w_gate) * (h @ w_up)) @ w_down


def _causal_short_conv(u, w, b):
    s = u.shape[1]
    up = jnp.pad(u, ((0, 0), (CONV_W - 1, 0), (0, 0)))
    out = b
    for tap in range(CONV_W):
        out = out + w[tap] * up[:, tap:tap + s, :]
    return out


def _gla_chunk_step(state, chunk):
    q, k, v, lcum = chunk
    decay = jnp.exp(-jnp.abs(lcum[:, :, :, None, :] - lcum[:, :, None, :, :]))
    scores = jnp.einsum('bhid,bhjd,bhijd->bhij', q, k, decay)
    o = jnp.einsum('bhij,bhjv->bhiv', scores, v) + jnp.einsum('bhid,bhdv->bhiv', q * jnp.exp(lcum), state)
    l_last = lcum[:, :, -1, :]
    k_dec = k * jnp.exp(l_last[:, :, None, :] - lcum)
    new_state = jnp.exp(l_last)[..., None] * state + jnp.einsum('bhjd,bhjv->bhdv', k_dec, v)
    return new_state, o


def _gla(q, k, v, log_alpha):
    b, s, _ = q.shape
    n = s // CHUNK

    def to_chunks(t, hd):
        return t.reshape(b, n, CHUNK, GLA_HEADS, hd).transpose(1, 0, 3, 2, 4).astype(jnp.float32)

    qc = to_chunks(q, HEAD_K) * (HEAD_K ** -0.5)
    kc = to_chunks(k, HEAD_K)
    vc = to_chunks(v, HEAD_V)
    lc = jnp.cumsum(to_chunks(log_alpha, HEAD_K), axis=3)
    s0 = jnp.zeros((b, GLA_HEADS, HEAD_K, HEAD_V), jnp.float32)
    _, o = lax.scan(_gla_chunk_step, s0, (qc, kc, vc, lc))
    return o.transpose(1, 0, 3, 2, 4).reshape(b, s, GLA_HEADS, HEAD_V)


def _mixer(h, w_in, conv_w, conv_b, w_conv_out, w_alpha_up, b_alpha, gla_norm_g, w_gla_out, b_merge, w_mix_out):
    b, s, _ = h.shape
    split_points = tuple(np.cumsum(IN_SPLIT_SIZES)[:-1].tolist())
    proj = h @ w_in
    cb, cc, cu, q, k, v, r, a_low, g_a, g_b = jnp.split(proj, split_points, axis=-1)
    y_a = (cb * _causal_short_conv(cc * cu, conv_w, conv_b)) @ w_conv_out
    log_alpha = jax.nn.log_sigmoid((a_low @ w_alpha_up + b_alpha).astype(jnp.float32)) / GATE_TEMP
    o = _rmsnorm(_gla(q, k, v, log_alpha), gla_norm_g)
    o = o.astype(h.dtype).reshape(b, s, D_GLA_V) * jax.nn.silu(r)
    y_b = o @ w_gla_out
    merged = jax.nn.sigmoid(g_a + b_merge[0]) * y_a + jax.nn.sigmoid(g_b + b_merge[1]) * y_b
    return merged @ w_mix_out


def setup_inputs(seed: int = 0) -> dict:
    key = jax.random.key(seed)
    ks = jax.random.split(key, 22)

    def nrm(k, shape, scale):
        return jax.random.normal(k, shape, jnp.float32) * scale

    def gain(k, shape):
        return 1.0 + 0.02 * jax.random.normal(k, shape, jnp.float32)

    L = DEPTH
    return {
        "x": nrm(ks[0], (BATCH, SEQ, D_MODEL), 1.0),
        "ffn1_norm_g": gain(ks[1], (L, D_MODEL)),
        "ffn1_w_gate": nrm(ks[2], (L, D_MODEL, D_FF), D_MODEL ** -0.5),
        "ffn1_w_up": nrm(ks[3], (L, D_MODEL, D_FF), D_MODEL ** -0.5),
        "ffn1_w_down": nrm(ks[4], (L, D_FF, D_MODEL), D_FF ** -0.5),
        "mix_norm_g": gain(ks[5], (L, D_MODEL)),
        "w_in": nrm(ks[6], (L, D_MODEL, D_IN), D_MODEL ** -0.5),
        "conv_w": nrm(ks[7], (L, CONV_W, D_CONV), CONV_W ** -0.5),
        "conv_b": nrm(ks[8], (L, D_CONV), 0.02),
        "w_conv_out": nrm(ks[9], (L, D_CONV, D_MODEL), D_CONV ** -0.5),
        "w_alpha_up": nrm(ks[10], (L, GATE_RANK, D_GLA_K), GATE_RANK ** -0.5),
        "b_alpha": nrm(ks[11], (L, D_GLA_K), 0.02),
        "gla_norm_g": gain(ks[12], (L, HEAD_V)),
        "w_gla_out": nrm(ks[13], (L, D_GLA_V, D_MODEL), D_GLA_V ** -0.5),
        "b_merge": nrm(ks[14], (L, N_BRANCH, D_MODEL), 0.02),
        "w_mix_out": nrm(ks[15], (L, D_MODEL, D_MODEL), D_MODEL ** -0.5),
        "ffn2_norm_g": gain(ks[16], (L, D_MODEL)),
        "ffn2_w_gate": nrm(ks[17], (L, D_MODEL, D_FF), D_MODEL ** -0.5),
        "ffn2_w_up": nrm(ks[18], (L, D_MODEL, D_FF), D_MODEL ** -0.5),
        "ffn2_w_down": nrm(ks[19], (L, D_FF, D_MODEL), D_FF ** -0.5),
        "final_norm_g": gain(ks[20], (D_MODEL,)),
    }


def reference(x, ffn1_norm_g, ffn1_w_gate, ffn1_w_up, ffn1_w_down, mix_norm_g, w_in, conv_w, conv_b,
              w_conv_out, w_alpha_up, b_alpha, gla_norm_g, w_gla_out, b_merge, w_mix_out,
              ffn2_norm_g, ffn2_w_gate, ffn2_w_up, ffn2_w_down, final_norm_g):
    for l in range(DEPTH):
        x = x + FFN_RES * _swiglu(_rmsnorm(x, ffn1_norm_g[l]), ffn1_w_gate[l], ffn1_w_up[l], ffn1_w_down[l])
        x = x + _mixer(_rmsnorm(x, mix_norm_g[l]), w_in[l], conv_w[l], conv_b[l], w_conv_out[l],
                       w_alpha_up[l], b_alpha[l], gla_norm_g[l], w_gla_out[l], b_merge[l], w_mix_out[l])
        x = x + FFN_RES * _swiglu(_rmsnorm(x, ffn2_norm_g[l]), ffn2_w_gate[l], ffn2_w_up[l], ffn2_w_down[l])
    return _rmsnorm(x, final_norm_g)
```

```cpp
#include <hip/hip_runtime.h>
#include <cstdio>
#include <cstdint>
namespace pg8 {
#define PG8_LAS __attribute__((address_space(3)))
typedef unsigned short bf16_t;
typedef short bf16x8 __attribute__((ext_vector_type(8)));
typedef float f32x4 __attribute__((ext_vector_type(4)));
typedef unsigned u32x4 __attribute__((ext_vector_type(4)));
constexpr int BM = 256, BK = 64, HALF = 128, HTB = HALF * BK * 2  , STAGE_BYTES = 8 * HTB, NXCD = 8, WGM = 8;

__host__ __device__ __forceinline__ int lds_byte(int r, int c) { const int st = (r >> 4) * 2 + (c >> 5), rr = r & 15, cc = c & 31, ob = rr * 64 + cc * 2; return st * 1024 + (ob ^ (((ob >> 9) & 1) << 5)); }
__host__ __device__ __forceinline__ void stage_rc(int b, int& R, int& C) { const int st = b / 1024, sb = b % 1024, swz = sb ^ (((sb >> 9) & 1) << 5); R = (st >> 1) * 16 + swz / 64; C = (st & 1) * 32 + (swz % 64) / 2; }
__host__ __device__ __forceinline__ int perm32(int rho) { const int n = rho >> 4, i = rho & 15; return 8 * (i >> 2) + 4 * n + (i & 3); }

struct Unit { int pm, pn; };
struct Gemm { const bf16_t* A; const bf16_t* Bt; int M, N, K; };

struct StaticOrder {
    int nM, nN, nwg, G, c;
    __host__ __device__ void init(int M, int N, int G_, int c_) { nM = M / BM; nN = N / BM; nwg = nM * nN; G = G_; c = c_; }
    __host__ __device__ bool next(int i, Unit& u) const {
        const long L = (long)i * G + c; if (L >= nwg) return false;
        int wgid = (int)L; { const int q = nwg / NXCD, r = nwg % NXCD, xcd = wgid % NXCD, off = wgid / NXCD; wgid = (xcd < r ? xcd * (q + 1) : r * (q + 1) + (xcd - r) * q) + off; }
        const int nig = WGM * nN, gid = wgid / nig, fm = gid * WGM, gsz = (nM - fm) < WGM ? (nM - fm) : WGM;
        u.pm = fm + ((wgid % nig) % gsz); u.pn = (wgid % nig) / gsz; return true;
    }
    __device__ __forceinline__ void a_ready(const Unit&) const {}
    __device__ __forceinline__ void done(const Unit&) const {}
};
__device__ __forceinline__ unsigned cvt_pk_bf16(float lo, float hi) { unsigned r; asm volatile("v_cvt_pk_bf16_f32 %0, %1, %2" : "=v"(r) : "v"(lo), "v"(hi)); return r; }
typedef float f32x2 __attribute__((ext_vector_type(2)));
__device__ __forceinline__ float bf_lo(unsigned w) { return __uint_as_float(w << 16); }
__device__ __forceinline__ float bf_hi(unsigned w) { return __uint_as_float(w & 0xffff0000u); }
__device__ __forceinline__ float sigmoid_f(float x) { return __builtin_amdgcn_rcpf(1.0f + __expf(-x)); }
__device__ __forceinline__ float silu_f(float x) { return x * sigmoid_f(x); }

struct EpiSwiGLU {
    static constexpr bool PERM = true, AFTER_DRAIN = false;
    bf16_t* O; int ldc;
    __device__ __forceinline__ void operator()(const f32x4 (&acc)[2][2][4][2], const Unit& u, int wr, int wc, int fr, int fq) const {
        const int row0 = u.pm * BM + wr * 64 + fr, col0 = u.pn * HALF + wc * 32 + 8 * fq;
#pragma unroll
        for (int ai = 0; ai < 2; ++ai)
#pragma unroll
            for (int m = 0; m < 4; ++m) { bf16_t* rowp = O + (size_t)(row0 + ai * HALF + m * 16) * ldc + col0;
                const f32x4 g0 = acc[ai][0][m][0], g1 = acc[ai][0][m][1], u0 = acc[ai][1][m][0], u1 = acc[ai][1][m][1];
                f32x4 v0, v1;
#pragma unroll
                for (int j = 0; j < 4; ++j) { v0[j] = silu_f(g0[j]) * u0[j]; v1[j] = silu_f(g1[j]) * u1[j]; }
                u32x4 w; w.x = cvt_pk_bf16(v0[0], v0[1]); w.y = cvt_pk_bf16(v0[2], v0[3]); w.z = cvt_pk_bf16(v1[0], v1[1]); w.w = cvt_pk_bf16(v1[2], v1[3]);
                *(u32x4*)rowp = w; }
    }
};
struct EpiGateMerge {
    static constexpr bool PERM = true, AFTER_DRAIN = false; static constexpr int MID_T = 32;
    static constexpr float GB_MIN = -60.0f;
    const bf16_t* GA; const bf16_t* GB; int ldg; const float* bias; int nb; bf16_t* O; int ldc;
    __device__ __forceinline__ void mid(f32x4 (&acc)[2][2][4][2], const Unit& u, int wr, int wc, int fr, int fq) const {
        int row0 = u.pm * BM + wr * 64 + fr, col0 = u.pn * BM + wc * 32 + 8 * fq;
        asm volatile("" : "+v"(row0), "+v"(col0));
#pragma unroll
        for (int bj = 0; bj < 2; ++bj) { const f32x4 a0 = *(const f32x4*)(bias + col0 + bj * HALF), a1 = *(const f32x4*)(bias + col0 + bj * HALF + 4), b0 = *(const f32x4*)(bias + nb + col0 + bj * HALF), b1 = *(const f32x4*)(bias + nb + col0 + bj * HALF + 4);
#pragma unroll
            for (int ai = 0; ai < 2; ++ai)
#pragma unroll
                for (int m = 0; m < 4; ++m) { const size_t r = (size_t)(row0 + ai * HALF + m * 16);
                    const u32x4 ga = *(const u32x4*)(GA + r * ldg + col0 + bj * HALF), gb = *(const u32x4*)(GB + r * ldg + col0 + bj * HALF);
                    const float xa[8] = {bf_lo(ga.x) + a0[0], bf_hi(ga.x) + a0[1], bf_lo(ga.y) + a0[2], bf_hi(ga.y) + a0[3], bf_lo(ga.z) + a1[0], bf_hi(ga.z) + a1[1], bf_lo(ga.w) + a1[2], bf_hi(ga.w) + a1[3]};
                    const float xb[8] = {bf_lo(gb.x) + b0[0], bf_hi(gb.x) + b0[1], bf_lo(gb.y) + b0[2], bf_hi(gb.y) + b0[3], bf_lo(gb.z) + b1[0], bf_hi(gb.z) + b1[1], bf_lo(gb.w) + b1[2], bf_hi(gb.w) + b1[3]};
#pragma unroll
                    for (int j = 0; j < 4; ++j) { acc[ai][bj][m][0][j] *= (1.0f + __expf(-fmaxf(xb[j], GB_MIN))) * __builtin_amdgcn_rcpf(1.0f + __expf(-xa[j]));
                        acc[ai][bj][m][1][j] *= (1.0f + __expf(-fmaxf(xb[4 + j], GB_MIN))) * __builtin_amdgcn_rcpf(1.0f + __expf(-xa[4 + j])); }
                    asm volatile("" ::: "memory"); } }
    }
    __device__ __forceinline__ void operator()(const f32x4 (&acc)[2][2][4][2], const Unit& u, int wr, int wc, int fr, int fq) const {
        const int row0 = u.pm * BM + wr * 64 + fr, col0 = u.pn * BM + wc * 32 + 8 * fq;
#pragma unroll
        for (int bj = 0; bj < 2; ++bj) { const f32x4 b0 = *(const f32x4*)(bias + nb + col0 + bj * HALF), b1 = *(const f32x4*)(bias + nb + col0 + bj * HALF + 4);
#pragma unroll
            for (int ai = 0; ai < 2; ++ai)
#pragma unroll
                for (int m = 0; m < 4; ++m) { const size_t r = (size_t)(row0 + ai * HALF + m * 16);
                    const u32x4 g = *(const u32x4*)(GB + r * ldg + col0 + bj * HALF);
                    f32x4 s0, s1;
                    s0[0] = sigmoid_f(fmaxf(bf_lo(g.x) + b0[0], GB_MIN)); s0[1] = sigmoid_f(fmaxf(bf_hi(g.x) + b0[1], GB_MIN)); s0[2] = sigmoid_f(fmaxf(bf_lo(g.y) + b0[2], GB_MIN)); s0[3] = sigmoid_f(fmaxf(bf_hi(g.y) + b0[3], GB_MIN));
                    s1[0] = sigmoid_f(fmaxf(bf_lo(g.z) + b1[0], GB_MIN)); s1[1] = sigmoid_f(fmaxf(bf_hi(g.z) + b1[1], GB_MIN)); s1[2] = sigmoid_f(fmaxf(bf_lo(g.w) + b1[2], GB_MIN)); s1[3] = sigmoid_f(fmaxf(bf_hi(g.w) + b1[3], GB_MIN));
                    const f32x4 v0 = s0 * acc[ai][bj][m][0], v1 = s1 * acc[ai][bj][m][1];
                    u32x4 w; w.x = cvt_pk_bf16(v0[0], v0[1]); w.y = cvt_pk_bf16(v0[2], v0[3]); w.z = cvt_pk_bf16(v1[0], v1[1]); w.w = cvt_pk_bf16(v1[2], v1[3]);
                    *(u32x4*)(O + r * ldc + col0 + bj * HALF) = w; } }
    }
};

struct EpiResidBf16 {
    static constexpr bool PERM = true, AFTER_DRAIN = false;
    const float* base; bf16_t* O; int ldc; float alpha;
    __device__ __forceinline__ void operator()(const f32x4 (&acc)[2][2][4][2], const Unit& u, int wr, int wc, int fr, int fq) const {
        const int row0 = u.pm * BM + wr * 64 + fr, col0 = u.pn * BM + wc * 32 + 8 * fq;
#pragma unroll
        for (int ai = 0; ai < 2; ++ai)
#pragma unroll
            for (int m = 0; m < 4; ++m) { const size_t off = (size_t)(row0 + ai * HALF + m * 16) * ldc + col0;
#pragma unroll
                for (int bj = 0; bj < 2; ++bj) { const f32x4 b0 = *(const f32x4*)(base + off + bj * HALF), b1 = *(const f32x4*)(base + off + bj * HALF + 4);
                    const f32x4 v0 = b0 + acc[ai][bj][m][0] * alpha, v1 = b1 + acc[ai][bj][m][1] * alpha;
                    u32x4 w; w.x = cvt_pk_bf16(v0[0], v0[1]); w.y = cvt_pk_bf16(v0[2], v0[3]); w.z = cvt_pk_bf16(v1[0], v1[1]); w.w = cvt_pk_bf16(v1[2], v1[3]);
                    *(u32x4*)(O + off + bj * HALF) = w; } }
    }
};
struct EpiResidStats {
    static constexpr bool PERM = true, AFTER_DRAIN = false;
    const float* base; float* out; int ldc; float alpha; bf16_t* XB; float* SSQ; const float* gain;
    __device__ __forceinline__ void operator()(const f32x4 (&acc)[2][2][4][2], const Unit& u, int wr, int wc, int fr, int fq) const {
        const int row0 = u.pm * BM + wr * 64 + fr, col0 = u.pn * BM + wc * 32 + 8 * fq;
#pragma unroll
        for (int ai = 0; ai < 2; ++ai)
#pragma unroll
            for (int m = 0; m < 4; ++m) { const size_t r = (size_t)(row0 + ai * HALF + m * 16); const size_t off = r * ldc + col0; float ss = 0.f;
#pragma unroll
                for (int bj = 0; bj < 2; ++bj) { const f32x4 b0 = *(const f32x4*)(base + off + bj * HALF), b1 = *(const f32x4*)(base + off + bj * HALF + 4);
                    const f32x4 g0 = *(const f32x4*)(gain + col0 + bj * HALF), g1 = *(const f32x4*)(gain + col0 + bj * HALF + 4);
                    const f32x4 v0 = b0 + acc[ai][bj][m][0] * alpha, v1 = b1 + acc[ai][bj][m][1] * alpha;
                    *(f32x4*)(out + off + bj * HALF) = v0; *(f32x4*)(out + off + bj * HALF + 4) = v1;
                    ss += (v0[0] * v0[0] + v0[1] * v0[1]) + (v0[2] * v0[2] + v0[3] * v0[3]) + (v1[0] * v1[0] + v1[1] * v1[1]) + (v1[2] * v1[2] + v1[3] * v1[3]);
                    const f32x4 x0 = v0 * g0, x1 = v1 * g1;
                    u32x4 w; w.x = cvt_pk_bf16(x0[0], x0[1]); w.y = cvt_pk_bf16(x0[2], x0[3]); w.z = cvt_pk_bf16(x1[0], x1[1]); w.w = cvt_pk_bf16(x1[2], x1[3]);
                    *(u32x4*)(XB + off + bj * HALF) = w; }
                ss += __shfl_xor(ss, 16); ss += __shfl_xor(ss, 32);
                if (fq == 0) SSQ[r * 64 + u.pn * 4 + wc] = ss; }
    }
};
struct RstdOrder : StaticOrder {
    const float* ssq; PG8_LAS float* tab; float inv_n, eps;
    mutable int slot, pm0, pm1;
    __device__ __forceinline__ void init_r(const float* ssq_, PG8_LAS float* tab_, float inv_n_, float eps_) { ssq = ssq_; tab = tab_; inv_n = inv_n_; eps = eps_; slot = 0; pm0 = -1; pm1 = -1; }
    __device__ __forceinline__ void a_ready(const Unit& u) const {
        if ((slot ? pm1 : pm0) == u.pm) return;
        slot ^= 1; if (slot) pm1 = u.pm; else pm0 = u.pm;
        const int t = threadIdx.x, row = t >> 1, part = t & 1;
        const f32x4* p = (const f32x4*)(ssq + (size_t)(u.pm * BM + row) * 64 + part * 32);
        float s = 0.f;
#pragma unroll
        for (int j = 0; j < 8; ++j) { const f32x4 v = p[j]; s += (v[0] + v[1]) + (v[2] + v[3]); }
        s += __shfl_xor(s, 1);
        if (part == 0) tab[slot * 256 + row] = 1.0f / sqrtf(s * inv_n + eps);
        asm volatile("s_waitcnt lgkmcnt(0)" ::: "memory"); __builtin_amdgcn_s_barrier(); asm volatile("" ::: "memory");
    }
    __device__ __forceinline__ const PG8_LAS float* table(const Unit& u) const { return tab + ((pm0 == u.pm) ? 0 : 256); }
};
struct EpiSwiGLUR {
    static constexpr bool PERM = true, AFTER_DRAIN = false;
    bf16_t* O; int ldc; const RstdOrder* S;
    __device__ __forceinline__ void operator()(const f32x4 (&acc)[2][2][4][2], const Unit& u, int wr, int wc, int fr, int fq) const {
        const int row0 = u.pm * BM + wr * 64 + fr, col0 = u.pn * HALF + wc * 32 + 8 * fq; const PG8_LAS float* tb = S->table(u) + wr * 64 + fr;
#pragma unroll
        for (int ai = 0; ai < 2; ++ai)
#pragma unroll
            for (int m = 0; m < 4; ++m) { bf16_t* rowp = O + (size_t)(row0 + ai * HALF + m * 16) * ldc + col0; const float rs = tb[ai * HALF + m * 16];
                const f32x4 g0 = acc[ai][0][m][0] * rs, g1 = acc[ai][0][m][1] * rs, u0 = acc[ai][1][m][0] * rs, u1 = acc[ai][1][m][1] * rs;
                f32x4 v0, v1;
#pragma unroll
                for (int j = 0; j < 4; ++j) { v0[j] = silu_f(g0[j]) * u0[j]; v1[j] = silu_f(g1[j]) * u1[j]; }
                u32x4 w; w.x = cvt_pk_bf16(v0[0], v0[1]); w.y = cvt_pk_bf16(v0[2], v0[3]); w.z = cvt_pk_bf16(v1[0], v1[1]); w.w = cvt_pk_bf16(v1[2], v1[3]);
                *(u32x4*)rowp = w; }
    }
};
struct EpiBf16R {
    static constexpr bool PERM = true, AFTER_DRAIN = false;
    bf16_t* O; int ldc; const RstdOrder* S;
    __device__ __forceinline__ void operator()(const f32x4 (&acc)[2][2][4][2], const Unit& u, int wr, int wc, int fr, int fq) const {
        const int row0 = u.pm * BM + wr * 64 + fr, col0 = u.pn * BM + wc * 32 + 8 * fq; const PG8_LAS float* tb = S->table(u) + wr * 64 + fr;
#pragma unroll
        for (int ai = 0; ai < 2; ++ai)
#pragma unroll
            for (int m = 0; m < 4; ++m) { bf16_t* rowp = O + (size_t)(row0 + ai * HALF + m * 16) * ldc + col0; const float rs = tb[ai * HALF + m * 16];
#pragma unroll
                for (int bj = 0; bj < 2; ++bj) { const f32x4 v0 = acc[ai][bj][m][0] * rs, v1 = acc[ai][bj][m][1] * rs;
                    u32x4 w; w.x = cvt_pk_bf16(v0[0], v0[1]); w.y = cvt_pk_bf16(v0[2], v0[3]); w.z = cvt_pk_bf16(v1[0], v1[1]); w.w = cvt_pk_bf16(v1[2], v1[3]);
                    *(u32x4*)(rowp + bj * HALF) = w; } }
    }
};

template <class T, class = void> struct epi_has_mid { static constexpr bool value = false; };
template <class T> struct epi_has_mid<T, decltype((void)T::MID_T)> { static constexpr bool value = true; };
template <class Epi, class Sched, bool ALIGN_EPI = false, bool SP2 = false>
__device__ __forceinline__ void gemm_phase(PG8_LAS unsigned char* lds, const Gemm g, const Sched& S, const Epi& E) {
    const int tid = threadIdx.x, wid = __builtin_amdgcn_readfirstlane(tid >> 6), lane = tid & 63, wr = wid >> 2, wc = wid & 3, fr = lane & 15, fq = lane >> 4;
    const int K = g.K, nt = K / BK;
    unsigned voffA[2], voffB[2];
#pragma unroll
    for (int i = 0; i < 2; ++i) { int R, C; stage_rc(tid * 16 + i * 8192, R, C); const int Rb = Epi::PERM ? ((R & ~31) + perm32(R & 31)) : R;
        voffA[i] = (unsigned)(R * K + C) * 2u; voffB[i] = (unsigned)(Rb * K + C) * 2u; }
    const size_t kstep = (size_t)(BK * 2);
    const size_t hstep = (size_t)HALF * K * 2;
    const size_t tstep = 2 * hstep;
    const unsigned ldsw = (unsigned)wid * 1024u;
    const int aoff = lds_byte(wr * 64 + fr, fq * 8), boff = lds_byte(wc * 32 + fr, fq * 8);
#define PG8_SA(b, h) (((b) * 2 + (h)) * HTB)
#define PG8_SB(b, h) ((4 + (b) * 2 + (h)) * HTB)
#define PG8_STAGE(bufoff, gbase, voff) do { _Pragma("unroll") for (int _i = 0; _i < 2; ++_i) \
        __builtin_amdgcn_global_load_lds((const unsigned*)((const char*)(gbase) + (voff)[_i]), (PG8_LAS unsigned*)(lds + (bufoff) + ldsw + _i * 8192), 16, 0, 0); } while (0)
#define PG8_LDA(dst, b, h) do { _Pragma("unroll") for (int m = 0; m < 4; ++m) _Pragma("unroll") for (int k = 0; k < 2; ++k) dst[m][k] = *(const PG8_LAS bf16x8*)(lds + PG8_SA(b, h) + aoff + m * 2048 + k * 1024); } while (0)
#define PG8_LDB(dst, b, h) do { _Pragma("unroll") for (int n = 0; n < 2; ++n) _Pragma("unroll") for (int k = 0; k < 2; ++k) dst[n][k] = *(const PG8_LAS bf16x8*)(lds + PG8_SB(b, h) + boff + n * 2048 + k * 1024); } while (0)
#define PG8_MMA(ai, bj, At, Bt) do { __builtin_amdgcn_s_setprio(1); _Pragma("unroll") for (int m = 0; m < 4; ++m) _Pragma("unroll") for (int n = 0; n < 2; ++n) _Pragma("unroll") for (int k = 0; k < 2; ++k) \
        acc[ai][bj][m][n] = __builtin_amdgcn_mfma_f32_16x16x32_bf16(Bt[n][k], At[m][k], acc[ai][bj][m][n], 0, 0, 0); __builtin_amdgcn_s_setprio(0); } while (0)
#define PG8_WAIT_V(n) asm volatile("s_waitcnt vmcnt(" #n ")" ::: "memory")
#define PG8_WAIT_L(n) asm volatile("s_waitcnt lgkmcnt(" #n ")" ::: "memory")
#define PG8_BAR __builtin_amdgcn_s_barrier()
#define PG8_SCHED __builtin_amdgcn_sched_barrier(0)
    Unit cur, nxt; int ui = 0;
    if (!S.next(0, cur)) return;
    f32x4 acc[2][2][4][2];
#pragma unroll
    for (int a = 0; a < 2; ++a)
#pragma unroll
        for (int b = 0; b < 2; ++b)
#pragma unroll
            for (int m = 0; m < 4; ++m)
#pragma unroll
                for (int n = 0; n < 2; ++n) acc[a][b][m][n] = (f32x4){0.f, 0.f, 0.f, 0.f};
    bf16x8 At[4][2], B0[2][2], B1[2][2];
    const char* cA = (const char*)g.A + (size_t)cur.pm * tstep; const char* cB = (const char*)g.Bt + (size_t)cur.pn * tstep;
    S.a_ready(cur);
    if constexpr (SP2) {
        PG8_STAGE(PG8_SB(0, 0), cB, voffB); PG8_STAGE(PG8_SB(0, 1), cB + hstep, voffB); PG8_STAGE(PG8_SA(0, 0), cA, voffA); PG8_STAGE(PG8_SA(0, 1), cA + hstep, voffA);
        if (wr == 1) PG8_BAR;
        PG8_WAIT_V(2); PG8_BAR;
        PG8_STAGE(PG8_SB(1, 0), cB + kstep, voffB); PG8_STAGE(PG8_SA(1, 0), cA + kstep, voffA); PG8_STAGE(PG8_SB(1, 1), cB + hstep + kstep, voffB);
        PG8_WAIT_V(6); PG8_BAR;
    } else {
        PG8_STAGE(PG8_SB(0, 0), cB, voffB); PG8_STAGE(PG8_SA(0, 0), cA, voffA); PG8_STAGE(PG8_SB(0, 1), cB + hstep, voffB); PG8_STAGE(PG8_SA(0, 1), cA + hstep, voffA);
        if (wr == 1) PG8_BAR;
        PG8_WAIT_V(4); PG8_BAR;
        PG8_STAGE(PG8_SB(1, 0), cB + kstep, voffB); PG8_STAGE(PG8_SA(1, 0), cA + kstep, voffA); PG8_STAGE(PG8_SB(1, 1), cB + hstep + kstep, voffB);
        PG8_WAIT_V(6); PG8_BAR;
    }
    for (;;) {
        const bool has_next = S.next(ui + 1, nxt);
        const char* nA = has_next ? (const char*)g.A + (size_t)nxt.pm * tstep : cA; const char* nB = has_next ? (const char*)g.Bt + (size_t)nxt.pn * tstep : cB;
        for (int t = 0; t < nt; t += 2) {
            const bool last = (t == nt - 2);
            const char* a1 = cA + (size_t)(t + 1) * kstep;
            const char* a2 = last ? nA : cA + (size_t)(t + 2) * kstep; const char* b2 = last ? nB : cB + (size_t)(t + 2) * kstep;
            const char* a3 = a2 + kstep; const char* b3 = b2 + kstep;
            if (last && has_next) S.a_ready(nxt);
            if constexpr (epi_has_mid<Epi>::value) { if (t == Epi::MID_T) E.mid(acc, cur, wr, wc, fr, fq); }
            if constexpr (SP2) {
            PG8_LDB(B0, 0, 0); PG8_LDB(B1, 0, 1); PG8_SCHED; PG8_LDA(At, 0, 0); PG8_STAGE(PG8_SA(1, 1), a1 + hstep, voffA);
            PG8_WAIT_V(8); PG8_WAIT_L(0); PG8_BAR; PG8_MMA(0, 0, At, B0); PG8_MMA(0, 1, At, B1); PG8_BAR; PG8_SCHED;
            PG8_LDA(At, 0, 1); PG8_STAGE(PG8_SB(0, 0), b2, voffB); PG8_STAGE(PG8_SB(0, 1), b2 + hstep, voffB); PG8_STAGE(PG8_SA(0, 0), a2, voffA);
            PG8_WAIT_V(8); PG8_WAIT_L(0); PG8_BAR; PG8_MMA(1, 0, At, B0); PG8_MMA(1, 1, At, B1); PG8_BAR; PG8_SCHED;
            PG8_LDB(B0, 1, 0); PG8_LDB(B1, 1, 1); PG8_SCHED; PG8_LDA(At, 1, 0); PG8_STAGE(PG8_SA(0, 1), a2 + hstep, voffA);
            PG8_WAIT_V(8); PG8_WAIT_L(0); PG8_BAR; PG8_MMA(0, 0, At, B0); PG8_MMA(0, 1, At, B1); PG8_BAR; PG8_SCHED;
            PG8_LDA(At, 1, 1); PG8_STAGE(PG8_SB(1, 0), b3, voffB); PG8_STAGE(PG8_SB(1, 1), b3 + hstep, voffB); PG8_STAGE(PG8_SA(1, 0), a3, voffA);
            PG8_WAIT_V(8); PG8_WAIT_L(0); PG8_BAR; PG8_MMA(1, 0, At, B0); PG8_MMA(1, 1, At, B1); PG8_BAR; PG8_SCHED;
            } else {
            PG8_LDB(B0, 0, 0); PG8_SCHED; PG8_LDA(At, 0, 0); PG8_STAGE(PG8_SA(1, 1), a1 + hstep, voffA);
            PG8_WAIT_L(8); PG8_BAR; PG8_WAIT_L(0); PG8_MMA(0, 0, At, B0); PG8_BAR; PG8_SCHED;
            PG8_LDB(B1, 0, 1); PG8_STAGE(PG8_SB(0, 0), b2, voffB);
            PG8_BAR; PG8_WAIT_L(0); PG8_MMA(0, 1, At, B1); PG8_BAR;
            PG8_LDA(At, 0, 1); PG8_STAGE(PG8_SA(0, 0), a2, voffA);
            PG8_BAR; PG8_WAIT_L(0); PG8_MMA(1, 0, At, B0); PG8_BAR; PG8_SCHED;
            PG8_STAGE(PG8_SB(0, 1), b2 + hstep, voffB);
            PG8_WAIT_V(6); PG8_BAR; PG8_MMA(1, 1, At, B1); PG8_BAR;
            PG8_LDB(B0, 1, 0); PG8_SCHED; PG8_LDA(At, 1, 0); PG8_STAGE(PG8_SA(0, 1), a2 + hstep, voffA);
            PG8_WAIT_L(8); PG8_BAR; PG8_WAIT_L(0); PG8_MMA(0, 0, At, B0); PG8_BAR; PG8_SCHED;
            PG8_LDB(B1, 1, 1); PG8_STAGE(PG8_SB(1, 0), b3, voffB);
            PG8_BAR; PG8_WAIT_L(0); PG8_MMA(0, 1, At, B1); PG8_BAR;
            PG8_LDA(At, 1, 1); PG8_STAGE(PG8_SA(1, 0), a3, voffA);
            PG8_BAR; PG8_WAIT_L(0); PG8_MMA(1, 0, At, B0); PG8_BAR; PG8_SCHED;
            PG8_STAGE(PG8_SB(1, 1), b3 + hstep, voffB);
            PG8_WAIT_V(6); PG8_BAR; PG8_MMA(1, 1, At, B1); PG8_BAR;
            }
        }
        if constexpr (ALIGN_EPI) { if (wr == 0) PG8_BAR; }
        if constexpr (!Epi::AFTER_DRAIN) { E(acc, cur, wr, wc, fr, fq); S.done(cur); }
        if (!has_next) break;
#pragma unroll
        for (int a = 0; a < 2; ++a)
#pragma unroll
            for (int b = 0; b < 2; ++b)
#pragma unroll
                for (int m = 0; m < 4; ++m)
#pragma unroll
                    for (int n = 0; n < 2; ++n) acc[a][b][m][n] = (f32x4){0.f, 0.f, 0.f, 0.f};
        cur = nxt; cA = nA; cB = nB; ++ui;
        if constexpr (ALIGN_EPI) { if (wr == 1) PG8_BAR; }
    }
    PG8_WAIT_V(0);
    if constexpr (!ALIGN_EPI) { if (wr == 0) PG8_BAR; }
    PG8_BAR;
    if constexpr (Epi::AFTER_DRAIN) { E.fused(acc, cur, wr, wc, fr, fq, lds, wid, lane); S.done(cur); }
#undef PG8_SA
#undef PG8_SB
#undef PG8_STAGE
#undef PG8_LDA
#undef PG8_LDB
#undef PG8_MMA
#undef PG8_WAIT_V
#undef PG8_WAIT_L
#undef PG8_BAR
#undef PG8_SCHED
}
}

constexpr int NWAVES = 8;
constexpr int DM = 4096, BATCH = 4, SEQ = 2048, M = BATCH * SEQ, DFF = 11008;
constexpr int DCONV = 2048, GH = 4, DGK = 1024, DGV = 2048, HK = 256, HV = 512, GRANK = 16, CHUNK = 64, NCHUNK = SEQ / CHUNK;
constexpr int DIN_SRC = 20496;
constexpr int LDP = 20480;
constexpr int PC_CB = 0, PC_CC = 2048, PC_CU = 4096, PC_Q = 6144, PC_K = 7168, PC_V = 8192, PC_R = 10240, PC_GA = 12288, PC_GB = 16384;
constexpr float EPS = 1e-6f;

constexpr size_t MiB = 1u << 20;
constexpr size_t WS_CTL = 0, CTL_ZERO_BYTES = 1 * MiB;
constexpr size_t SZ_WGU = (size_t)2 * DFF * DM * 2, SZ_WD = (size_t)DM * DFF * 2, SZ_WIN = (size_t)LDP * DM * 2;
constexpr size_t WS_WGU1 = 1 * MiB;
constexpr size_t WS_WD1 = WS_WGU1 + SZ_WGU;
constexpr size_t WS_WIN = WS_WD1 + SZ_WD;
constexpr size_t WS_WCO = WS_WIN + SZ_WIN;
constexpr size_t WS_WGO = WS_WCO + (size_t)DM * DCONV * 2;
constexpr size_t WS_WMO = WS_WGO + (size_t)DM * DGV * 2;
constexpr size_t WS_WGU2 = WS_WMO + (size_t)DM * DM * 2;
constexpr size_t WS_WD2 = WS_WGU2 + SZ_WGU;
constexpr size_t WS_H = WS_WD2 + SZ_WD;
constexpr size_t WS_ACT = WS_H + (size_t)M * DM * 2;
constexpr size_t WS_SC = WS_ACT + (size_t)M * LDP * 2;
constexpr size_t WS_OG = WS_SC + (size_t)BATCH * NCHUNK * GH * 64 * 64 * 4;
constexpr size_t WS_OP = WS_OG + (size_t)M * DGV * 4;
constexpr size_t WS_CA = WS_OP + (size_t)M * DGV * 2;
constexpr size_t WS_MG = WS_CA + (size_t)M * DCONV * 2;
constexpr size_t WS_QA = WS_MG + (size_t)M * DM * 2;
constexpr size_t WS_KDT = WS_QA + (size_t)M * DGK * 2;
constexpr size_t WS_VT = WS_KDT + (size_t)M * DGK * 2;
constexpr size_t WS_GAM = WS_VT + (size_t)M * DGV * 2;
constexpr size_t WS_SSQ = WS_GAM + (size_t)BATCH * NCHUNK * GH * HK * 4;
constexpr size_t WS_AL = WS_SSQ + (size_t)M * 64 * 4;
constexpr size_t WS_WA = WS_AL + (size_t)M * 16 * 4;
constexpr size_t WS_END = WS_WA + (size_t)64 * DM * 2;
static_assert(WS_WGU1 % 256 == 0 && WS_WD1 % 256 == 0 && WS_WIN % 256 == 0 && WS_H % 256 == 0 && WS_ACT % 256 == 0 && WS_SC % 256 == 0 && WS_QA % 256 == 0, "alignment");
constexpr int CW_TMO = 0;
constexpr int CW_BAR = 4096;

constexpr int RING_OFF = 0, RING_BYTES = 131072;
constexpr int LDS_BYTES = 155648;
constexpr int MISC_OFF = LDS_BYTES - 256;
constexpr int RTAB_OFF = RING_BYTES;
static_assert(RING_BYTES + 2048 <= LDS_BYTES - 256, "LDS map");

constexpr int NPHASE = 12;
constexpr bool SCAN_SPLIT = true; constexpr int SCAN_UP_BLK = 88;
constexpr bool TAIL_CONV = true; constexpr int TAIL_W0 = 192;

#define GAS __attribute__((address_space(1)))
#define LAS __attribute__((address_space(3)))
typedef unsigned short bf16;
typedef unsigned v4u __attribute__((ext_vector_type(4)));
typedef unsigned v2u __attribute__((ext_vector_type(2)));
typedef float f32x4 __attribute__((ext_vector_type(4)));
typedef GAS unsigned gu32;
#define RLX_AGENT __ATOMIC_RELAXED, __HIP_MEMORY_SCOPE_AGENT
#define LDS_WAIT() asm volatile("s_waitcnt lgkmcnt(0)" ::: "memory")
#define VM_WAIT() asm volatile("s_waitcnt vmcnt(0)" ::: "memory")
__device__ __forceinline__ unsigned f2bf(float f) { unsigned u = __builtin_bit_cast(unsigned, f); return (u + 0x7fffu + ((u >> 16) & 1u)) >> 16; }
__device__ __forceinline__ unsigned pk2(float lo, float hi) { return f2bf(lo) | (f2bf(hi) << 16); }
typedef float f32x2_t __attribute__((ext_vector_type(2))); typedef __bf16 bf16x2_t __attribute__((ext_vector_type(2)));
__device__ __forceinline__ unsigned cvtpk(float lo, float hi) { f32x2_t v = {lo, hi}; bf16x2_t b = __builtin_convertvector(v, bf16x2_t); return __builtin_bit_cast(unsigned, b); }
__device__ __forceinline__ float bf2f(bf16 b) { return __uint_as_float(((unsigned)b) << 16); }
__device__ __forceinline__ float bflo(unsigned w) { return __uint_as_float(w << 16); }
__device__ __forceinline__ float bfhi(unsigned w) { return __uint_as_float(w & 0xffff0000u); }

#define XB_TMO      128
#define XB_XCNT(j)  (256  + 64 * (j))
#define XB_XSUB(j)  (1280 + 64 * (j))
#define XB_XGEN(j)  (2304 + 64 * (j))
#define XB_TOP      3328
#define XB_TOPGEN   3392
#define XCD_BAR_WORDS 3456
#define XB_SPIN_CAP (1u << 18)

__device__ __forceinline__ unsigned xb_ld(unsigned* p)              { return __hip_atomic_load(p, __ATOMIC_RELAXED, __HIP_MEMORY_SCOPE_AGENT); }
__device__ __forceinline__ unsigned xb_add(unsigned* p, unsigned v) { return __hip_atomic_fetch_add(p, v, __ATOMIC_RELAXED, __HIP_MEMORY_SCOPE_AGENT); }
__device__ __forceinline__ unsigned xb_xcc_id() { return (unsigned)__builtin_amdgcn_s_getreg((3 << 11) | 20) & 0xFu; }
#define XB_SPIN(cond, bar) do { unsigned _sp = 0; while (cond) { __builtin_amdgcn_s_sleep(1); \
    if ((++_sp & 255u) == 0u) { if (xb_ld(&(bar)[XB_TMO])) break; if (_sp > XB_SPIN_CAP) { atomicAdd(&(bar)[XB_TMO], 1u); break; } } } } while (0)

struct XcdBarrier {
    unsigned* bar; unsigned x;
    volatile LAS unsigned* st;
};

__device__ __forceinline__ XcdBarrier xcd_barrier_post(unsigned* bar, volatile LAS unsigned* st) {
    XcdBarrier b; b.bar = bar; b.x = xb_xcc_id(); b.st = st;
    if (threadIdx.x == 0) (void)xb_add(&bar[XB_XCNT(b.x)], 1u);
    return b;
}
__device__ __forceinline__ void xcd_barrier_complete(unsigned* bar, unsigned x, unsigned& nloc, unsigned& nx) {
    const unsigned G = gridDim.x * gridDim.y * gridDim.z;
    unsigned sum, cnt, mine, sp = 0u;
    for (;;) {
        sum = 0u; cnt = 0u; mine = 0u;
#pragma unroll
        for (unsigned j = 0; j < 16; ++j) { const unsigned c = xb_ld(&bar[XB_XCNT(j)]); sum += c; cnt += (c > 0u) ? 1u : 0u; mine = (j == x) ? c : mine; }
        if (sum == G) break;
        __builtin_amdgcn_s_sleep(1);
        if ((++sp & 255u) == 0u) { if (xb_ld(&bar[XB_TMO])) break; if (sp > XB_SPIN_CAP) { atomicAdd(&bar[XB_TMO], 1u); break; } }
    }
    nloc = mine > 0u ? mine : 1u; nx = cnt > 0u ? cnt : 1u;
}

__device__ __forceinline__ void xcd_barrier(const XcdBarrier& b) {
    asm volatile("s_waitcnt vmcnt(0)" ::: "memory");
    __syncthreads();
    if (threadIdx.x == 0) {
        unsigned* bar = b.bar;
        __builtin_amdgcn_s_waitcnt(0);
        unsigned nloc = b.st[0], nx = b.st[1];
        if (nloc == 0u) { xcd_barrier_complete(bar, b.x, nloc, nx); b.st[0] = nloc; b.st[1] = nx; }
        const unsigned old = xb_add(&bar[XB_XSUB(b.x)], 1u);
        const unsigned gen = old / nloc;
        if (old + 1u == (gen + 1u) * nloc) {
            __builtin_amdgcn_fence(__ATOMIC_RELEASE, "agent");
            asm volatile("s_waitcnt vmcnt(0)" ::: "memory");
            const unsigned og = xb_add(&bar[XB_TOP], 1u);
            const unsigned tg = og / nx;
            if (og + 1u == (tg + 1u) * nx) xb_add(&bar[XB_TOPGEN], 1u);
            else XB_SPIN(xb_ld(&bar[XB_TOPGEN]) == tg, bar);
            __builtin_amdgcn_fence(__ATOMIC_ACQUIRE, "agent");
            xb_add(&bar[XB_XGEN(b.x)], 1u);
            asm volatile("s_waitcnt vmcnt(0)" ::: "memory");
        } else {
            XB_SPIN(xb_ld(&bar[XB_XGEN(b.x)]) == gen, bar);
            __builtin_amdgcn_fence(__ATOMIC_ACQUIRE, "agent");
            asm volatile("s_waitcnt vmcnt(0)" ::: "memory");
        }
    }
    __syncthreads();
}

struct Frame {
    LAS unsigned char* lds;
    volatile LAS unsigned* MISC;
    gu32* ctl;
    int tid, lane, wave;
    int vcu, G;
};

__device__ __forceinline__ void unpack8(const v4u v, float (&o)[8]);
__device__ __forceinline__ float wave_sum(float v) {
#pragma unroll
    for (int o = 1; o < 64; o <<= 1) v += __shfl_xor(v, o);
    return v;
}

__device__ __forceinline__ void tr_item(const float* __restrict__ W, int ldw, bf16* __restrict__ WT, int K, int k0, int scol0, int nvalid, int drow0, LAS float* scr, int lane, const float* __restrict__ gk, int ldt, int koff) {
    const int c4 = (lane & 15) * 4, kr = lane >> 4;
    f32x4 v[16];
#pragma unroll
    for (int i = 0; i < 16; ++i) { v[i] = (f32x4){0.f, 0.f, 0.f, 0.f};
        if (c4 < nvalid) v[i] = __builtin_nontemporal_load((const f32x4*)(W + (size_t)(k0 + 4 * i + kr) * ldw + scol0 + c4)); }
    if (gk) {
#pragma unroll
        for (int i = 0; i < 16; ++i) v[i] = v[i] * gk[k0 + 4 * i + kr]; }
#pragma unroll
    for (int i = 0; i < 16; ++i) { LAS float* s = scr + (4 * i + kr) * 65 + c4; s[0] = v[i].x; s[1] = v[i].y; s[2] = v[i].z; s[3] = v[i].w; }
    LDS_WAIT();
    const int c = lane & 7, nn = lane >> 3;
#pragma unroll
    for (int jj = 0; jj < 8; ++jj) { const int n = 8 * jj + nn; const LAS float* s = scr + (8 * c) * 65 + n;
        v4u o; o.x = cvtpk(s[0], s[65]); o.y = cvtpk(s[130], s[195]); o.z = cvtpk(s[260], s[325]); o.w = cvtpk(s[390], s[455]);
        *(v4u*)(WT + (size_t)(drow0 + n) * ldt + koff + k0 + 8 * c) = o; }
    LDS_WAIT();
}
__device__ __forceinline__ void conv_seg(Frame& F, const float* W, int ldw, int K, int scol0, int nblk, int nvalid_first, int nvalid_rest, bf16* WT, int sh, int strideA, int off, LAS float* scr, const float* gk = nullptr, int gw_ = -1, int ngw_ = 0, int ldt = 0, int koff = 0) {
    const int gw = gw_ >= 0 ? gw_ : F.vcu * NWAVES + F.wave, NGW = gw_ >= 0 ? ngw_ : F.G * NWAVES;
    const int nitems = (K / 64) * nblk;
    for (int it = gw; it < nitems; it += NGW) { const int kb = it / nblk, nb = it - kb * nblk;
        const int drow = (nb >> sh) * strideA + (nb & ((1 << sh) - 1)) * 64 + off;
        tr_item(W, ldw, WT, K, kb * 64, scol0 + nb * 64, nb == 0 ? nvalid_first : nvalid_rest, drow, scr, F.lane, gk, ldt ? ldt : K, koff); }
}
#define GLD16NT(dst, ptr) asm volatile("global_load_dwordx4 %0, %1, off nt" : "=v"(dst) : "v"(ptr) : "memory")
#define TR_WAIT(v) asm volatile("s_waitcnt vmcnt(16)" : "+v"(v[0]), "+v"(v[1]), "+v"(v[2]), "+v"(v[3]), "+v"(v[4]), "+v"(v[5]), "+v"(v[6]), "+v"(v[7]), \
    "+v"(v[8]), "+v"(v[9]), "+v"(v[10]), "+v"(v[11]), "+v"(v[12]), "+v"(v[13]), "+v"(v[14]), "+v"(v[15]) :: "memory")
#define TR_DRAIN(v) asm volatile("s_waitcnt vmcnt(0)" : "+v"(v[0]), "+v"(v[1]), "+v"(v[2]), "+v"(v[3]), "+v"(v[4]), "+v"(v[5]), "+v"(v[6]), "+v"(v[7]), \
    "+v"(v[8]), "+v"(v[9]), "+v"(v[10]), "+v"(v[11]), "+v"(v[12]), "+v"(v[13]), "+v"(v[14]), "+v"(v[15]) :: "memory")
__device__ __forceinline__ void tr_issue(v4u (&v)[16], const float* W, int ldw, int k0, int scol0, int lane) {
    const float* p = W + (size_t)(k0 + (lane >> 4)) * ldw + scol0 + (lane & 15) * 4;
#pragma unroll
    for (int i = 0; i < 16; ++i) { const float* pi = p + (size_t)(4 * i) * ldw; GLD16NT(v[i], pi); }
}
__device__ __forceinline__ void tr_process(const v4u (&v)[16], bf16* __restrict__ WT, int K, int k0, int nvalid, int drow0, LAS float* scr, int lane, const float* __restrict__ gk, int ldt, int koff) {
    const int c4 = (lane & 15) * 4, kr = lane >> 4; const bool ok = c4 < nvalid;
#pragma unroll
    for (int i = 0; i < 16; ++i) { const float g = gk ? gk[k0 + 4 * i + kr] : 1.0f; LAS float* s = scr + (4 * i + kr) * 65 + c4;
        s[0] = ok ? __uint_as_float(v[i].x) * g : 0.f; s[1] = ok ? __uint_as_float(v[i].y) * g : 0.f; s[2] = ok ? __uint_as_float(v[i].z) * g : 0.f; s[3] = ok ? __uint_as_float(v[i].w) * g : 0.f; }
    LDS_WAIT();
    const int c = lane & 7, nn = lane >> 3;
#pragma unroll
    for (int jj = 0; jj < 8; ++jj) { const int n = 8 * jj + nn; const LAS float* s = scr + (8 * c) * 65 + n;
        v4u o; o.x = cvtpk(s[0], s[65]); o.y = cvtpk(s[130], s[195]); o.z = cvtpk(s[260], s[325]); o.w = cvtpk(s[390], s[455]);
        *(v4u*)(WT + (size_t)(drow0 + n) * ldt + koff + k0 + 8 * c) = o; }
    LDS_WAIT();
}
__device__ __forceinline__ void conv_seg_pipe(Frame& F, const float* W, int ldw, int K, int scol0, int nblk, int nvalid_first, int nvalid_rest, bf16* WT, int sh, int strideA, int off, LAS float* scr, const float* gk, int gw, int NGW, int ldt_ = 0, int koff = 0) {
    const int ldt = ldt_ ? ldt_ : K;
    const int nitems = (K / 64) * nblk;
    int it = gw; if (it >= nitems) return;
    v4u A[16], B[16];
    VM_WAIT();
    { const int kb = it / nblk, nb = it - kb * nblk; tr_issue(A, W, ldw, kb * 64, scol0 + nb * 64, F.lane); }
    for (;;) {
        { const int nx = it + NGW, has = nx < nitems, ix = has ? nx : it; const int kb = ix / nblk, nb = ix - kb * nblk; tr_issue(B, W, ldw, kb * 64, scol0 + nb * 64, F.lane);
          TR_WAIT(A);
          const int kc = it / nblk, nc = it - kc * nblk;
          tr_process(A, WT, K, kc * 64, nc == 0 ? nvalid_first : nvalid_rest, (nc >> sh) * strideA + (nc & ((1 << sh) - 1)) * 64 + off, scr, F.lane, gk, ldt, koff);
          if (!has) break; it = nx; }
        { const int nx = it + NGW, has = nx < nitems, ix = has ? nx : it; const int kb = ix / nblk, nb = ix - kb * nblk; tr_issue(A, W, ldw, kb * 64, scol0 + nb * 64, F.lane);
          TR_WAIT(B);
          const int kc = it / nblk, nc = it - kc * nblk;
          tr_process(B, WT, K, kc * 64, nc == 0 ? nvalid_first : nvalid_rest, (nc >> sh) * strideA + (nc & ((1 << sh) - 1)) * 64 + off, scr, F.lane, gk, ldt, koff);
          if (!has) break; it = nx; }
    }
    TR_DRAIN(A); TR_DRAIN(B);
}
__device__ __forceinline__ void rms_rows_bf16(Frame& F, const float* src, const float* g, bf16* dst) {
    const int gw = F.vcu * NWAVES + F.wave, NGW = F.G * NWAVES;
    for (int m = gw; m < M; m += NGW) {
        const f32x4* xr = (const f32x4*)(src + (size_t)m * DM) + F.lane;
        f32x4 v[16]; float s = 0.f;
#pragma unroll
        for (int j = 0; j < 16; ++j) { v[j] = xr[64 * j]; s += (v[j].x * v[j].x + v[j].y * v[j].y) + (v[j].z * v[j].z + v[j].w * v[j].w); }
        const float rstd = 1.0f / sqrtf(wave_sum(s) * (1.0f / DM) + EPS);
        const f32x4* gr = (const f32x4*)g + F.lane;
        v2u* o8 = (v2u*)(dst + (size_t)m * DM) + F.lane;
#pragma unroll
        for (int j = 0; j < 16; ++j) { const f32x4 gg = gr[64 * j]; v2u w; w.x = pk2(v[j].x * rstd * gg.x, v[j].y * rstd * gg.y); w.y = pk2(v[j].z * rstd * gg.z, v[j].w * rstd * gg.w); o8[64 * j] = w; }
    }
}
__device__ __forceinline__ void rms_rows_final(Frame& F, const bf16* src, float* dst, const float* g) {
    const int gw = F.vcu * NWAVES + F.wave, NGW = F.G * NWAVES;
    for (int m = gw; m < M; m += NGW) {
        const v4u* xr = (const v4u*)(src + (size_t)m * DM) + F.lane;
        v4u v[8]; float s = 0.f;
#pragma unroll
        for (int j = 0; j < 8; ++j) { v[j] = xr[64 * j]; float x[8]; unpack8(v[j], x);
#pragma unroll
            for (int e = 0; e < 8; ++e) s += x[e] * x[e]; }
        const float rstd = 1.0f / sqrtf(wave_sum(s) * (1.0f / DM) + EPS);
#pragma unroll
        for (int j = 0; j < 8; ++j) { float x[8]; unpack8(v[j], x); const int c = 8 * (F.lane + 64 * j);
            const f32x4 g0 = *(const f32x4*)(g + c), g1 = *(const f32x4*)(g + c + 4);
            f32x4* o = (f32x4*)(dst + (size_t)m * DM + c);
            o[0] = (f32x4){x[0] * rstd * g0.x, x[1] * rstd * g0.y, x[2] * rstd * g0.z, x[3] * rstd * g0.w};
            o[1] = (f32x4){x[4] * rstd * g1.x, x[5] * rstd * g1.y, x[6] * rstd * g1.z, x[7] * rstd * g1.w}; }
    }
}


__device__ __forceinline__ void unpack8(const v4u v, float (&o)[8]) { o[0] = bflo(v.x); o[1] = bfhi(v.x); o[2] = bflo(v.y); o[3] = bfhi(v.y); o[4] = bflo(v.z); o[5] = bfhi(v.z); o[6] = bflo(v.w); o[7] = bfhi(v.w); }
__device__ __forceinline__ void conv_branch(Frame& F, const bf16* PROJ, const float* conv_w, const float* conv_b, bf16* CA) {
    const int gt = blockIdx.x * 512 + F.tid, NT = F.G * 512;
    for (int p = gt; p < (M / 16) * (DCONV / 8); p += NT) { const int c = (p % (DCONV / 8)) * 8, t0 = (p / (DCONV / 8)) * 16; const int s0 = t0 % SEQ;
        float w0[8], w1[8], w2[8], bb[8], um2[8], um1[8];
#pragma unroll
        for (int e = 0; e < 8; e += 4) { const f32x4 a = *(const f32x4*)(conv_w + c + e), b1 = *(const f32x4*)(conv_w + DCONV + c + e), c2 = *(const f32x4*)(conv_w + 2 * DCONV + c + e), d = *(const f32x4*)(conv_b + c + e);
#pragma unroll
            for (int q = 0; q < 4; ++q) { w0[e + q] = a[q]; w1[e + q] = b1[q]; w2[e + q] = c2[q]; bb[e + q] = d[q]; } }
        const bf16* row = PROJ + (size_t)t0 * LDP + c;
        if (s0 > 0) { float a[8], b2[8]; unpack8(*(const v4u*)(row - 2 * (size_t)LDP + PC_CC), a); unpack8(*(const v4u*)(row - 2 * (size_t)LDP + PC_CU), b2);
#pragma unroll
            for (int e = 0; e < 8; ++e) um2[e] = a[e] * b2[e];
            unpack8(*(const v4u*)(row - (size_t)LDP + PC_CC), a); unpack8(*(const v4u*)(row - (size_t)LDP + PC_CU), b2);
#pragma unroll
            for (int e = 0; e < 8; ++e) um1[e] = a[e] * b2[e]; }
        else {
#pragma unroll
            for (int e = 0; e < 8; ++e) { um2[e] = 0.f; um1[e] = 0.f; } }
#pragma unroll 4
        for (int tt = 0; tt < 16; ++tt) { float cc[8], cu[8], cb[8], o[8];
            unpack8(*(const v4u*)(row + (size_t)tt * LDP + PC_CC), cc); unpack8(*(const v4u*)(row + (size_t)tt * LDP + PC_CU), cu); unpack8(*(const v4u*)(row + (size_t)tt * LDP + PC_CB), cb);
#pragma unroll
            for (int e = 0; e < 8; ++e) { const float u = cc[e] * cu[e]; o[e] = cb[e] * (bb[e] + w0[e] * um2[e] + w1[e] * um1[e] + w2[e] * u); um2[e] = um1[e]; um1[e] = u; }
            *(v4u*)(CA + (size_t)(t0 + tt) * (DCONV + DGV) + c) = (v4u){cvtpk(o[0], o[1]), cvtpk(o[2], o[3]), cvtpk(o[4], o[5]), cvtpk(o[6], o[7])}; }
    }
}

typedef short s16x8 __attribute__((ext_vector_type(8)));
typedef float f32x16 __attribute__((ext_vector_type(16)));
__device__ __forceinline__ int crow32(int reg, int hh) { return (reg & 3) + 8 * (reg >> 2) + 4 * hh; }

__device__ __forceinline__ void vt_transpose(Frame& F, const bf16* PROJ, bf16* VT) {
    LAS bf16* scr = (LAS bf16*)(F.lds + F.wave * 8448);
    const int gw = F.vcu * NWAVES + F.wave, NGW = F.G * NWAVES, lane = F.lane;
    for (int it = gw; it < (M / CHUNK) * (DGV / 64); it += NGW) { const int c = it >> 5, vb = it & 31;
#pragma unroll
        for (int k = 0; k < 8; ++k) { const int p = lane + 64 * k, tok = p >> 3, c8 = (p & 7) * 8;
            const v4u v = *(const v4u*)(PROJ + (size_t)(c * CHUNK + tok) * LDP + PC_V + vb * 64 + c8);
            LAS unsigned* d = (LAS unsigned*)(scr + tok * 66 + c8); d[0] = v.x; d[1] = v.y; d[2] = v.z; d[3] = v.w; }
        LDS_WAIT();
        const int cc = lane & 7, nn = lane >> 3;
#pragma unroll
        for (int jj = 0; jj < 8; ++jj) { const int dv = 8 * jj + nn; const LAS bf16* sp = scr + (8 * cc) * 66 + dv;
            v4u o; o.x = (unsigned)sp[0] | ((unsigned)sp[66] << 16); o.y = (unsigned)sp[132] | ((unsigned)sp[198] << 16); o.z = (unsigned)sp[264] | ((unsigned)sp[330] << 16); o.w = (unsigned)sp[396] | ((unsigned)sp[462] << 16);
            const int dvg = vb * 64 + dv;
            *(v4u*)(VT + ((((((size_t)c * GH + (dvg >> 9)) * 16 + ((dvg >> 5) & 15)) * 4 + (cc >> 1)) * 64 + 32 * (cc & 1) + (dvg & 31)) * 8)) = o; }
        LDS_WAIT();
    }
}
__device__ __forceinline__ size_t qaf_index(int item, int i, int d) { const int w = d >> 5, s = (d >> 4) & 1, dd = d & 15, hh = (dd >> 2) & 1, j = (dd & 3) + 4 * (dd >> 3);
    return ((((size_t)item * 8 + w) * 4 + (i >> 5) * 2 + s) * 64 + 32 * hh + (i & 31)) * 8 + j; }
__device__ __forceinline__ void gla_prep(Frame& F, const bf16* PROJ, const float* AL32, const float* w_up, const float* b_alpha, bf16* SC, bf16* QA, bf16* KDT, float* GAM) {
    LAS float* Lc = (LAS float*)(F.lds);
    LAS bf16* QX = (LAS bf16*)(F.lds + 65792);
    LAS bf16* KX = (LAS bf16*)(F.lds + 65792 + 33792);
    LAS float* tot = (LAS float*)(F.lds + 65792 + 2 * 33792);
    LAS float* AL = (LAS float*)(F.lds + 65792 + 2 * 33792 + 2048);
    const int tid = F.tid, lane = F.lane, r16 = lane & 15, q4 = lane >> 4;
    for (int item = blockIdx.x; item < BATCH * NCHUNK * GH; item += F.G) {
        const int h = item % GH, n = (item / GH) % NCHUNK, b = item / (GH * NCHUNK);
        const int r0 = b * SEQ + n * CHUNK;
        if (tid < 256) *(LAS f32x4*)(AL + tid * 4) = *(const f32x4*)(AL32 + (size_t)r0 * 16 + tid * 4);
        const int d = tid & 255, half = tid >> 8;
        for (int p = tid; p < 64 * 32; p += 512) { const int i = p >> 5, c8 = (p & 31) * 8;
            *(LAS v4u*)(QX + i * 264 + c8) = *(const v4u*)(PROJ + (size_t)(r0 + i) * LDP + PC_Q + h * HK + c8);
            *(LAS v4u*)(KX + i * 264 + c8) = *(const v4u*)(PROJ + (size_t)(r0 + i) * LDP + PC_K + h * HK + c8); }
        __syncthreads();
        unsigned qraw[32], kraw[32];
#pragma unroll
        for (int ii = 0; ii < 32; ++ii) { qraw[ii] = QX[(half * 32 + ii) * 264 + d]; kraw[ii] = KX[(half * 32 + ii) * 264 + d]; }
        __syncthreads();
        {
            float wu[GRANK];
#pragma unroll
            for (int r = 0; r < GRANK; ++r) wu[r] = w_up[r * DGK + h * HK + d];
            const float ba = b_alpha[h * HK + d];
            float run = 0.f;
#pragma unroll 4
            for (int ii = 0; ii < 32; ++ii) { const int i = half * 32 + ii;
                const LAS f32x4* ap = (const LAS f32x4*)(AL + i * 16); const f32x4 a0 = ap[0], a1 = ap[1], a2 = ap[2], a3 = ap[3];
                float z = ba;
                z += a0.x * wu[0] + a0.y * wu[1] + a0.z * wu[2] + a0.w * wu[3] + a1.x * wu[4] + a1.y * wu[5] + a1.z * wu[6] + a1.w * wu[7];
                z += a2.x * wu[8] + a2.y * wu[9] + a2.z * wu[10] + a2.w * wu[11] + a3.x * wu[12] + a3.y * wu[13] + a3.z * wu[14] + a3.w * wu[15];
                run += (fminf(z, 0.f) - __logf(1.0f + __expf(-fabsf(z)))) * (1.0f / 16.0f);
                Lc[i * 257 + d] = run; }
            tot[half * 256 + d] = run;
        }
        __syncthreads();
        const float t0 = tot[d], t1 = tot[256 + d], llast = t0 + t1, off = half ? t0 : 0.f;
#pragma unroll
        for (int g = 0; g < 4; ++g) {
            unsigned kdp[4];
#pragma unroll
            for (int e2 = 0; e2 < 4; ++e2) { float kd2[2];
#pragma unroll
                for (int e = 0; e < 2; ++e) { const int ii = g * 8 + e2 * 2 + e, i = half * 32 + ii;
                    const float Lv = Lc[i * 257 + d] + off; const float qv = __uint_as_float(qraw[ii] << 16), kv = __uint_as_float(kraw[ii] << 16);
                    const float ea = __expf(Lv), eb = __expf(-Lv);
                    QX[i * 264 + d] = (bf16)f2bf(qv * 0.0625f * ea);
                    KX[i * 264 + d] = (bf16)f2bf(kv * eb);
                    kd2[e] = kv * __expf(llast - Lv); }
                kdp[e2] = cvtpk(kd2[0], kd2[1]); }
            *(v4u*)(KDT + ((((size_t)item * 8 + (d >> 5)) * 4 + 2 * half + (g >> 1)) * 64 + 32 * (g & 1) + (d & 31)) * 8) = (v4u){kdp[0], kdp[1], kdp[2], kdp[3]};
        }
        if (half == 0) GAM[(size_t)item * HK + d] = __expf(llast);
        __syncthreads();
        {
            const int w = F.wave, r = lane & 31, hh = lane >> 5;
#pragma unroll
            for (int mt = 0; mt < 2; ++mt)
#pragma unroll
                for (int ks = 0; ks < 2; ++ks) { const LAS bf16* src = QX + (32 * mt + r) * 264 + 32 * w + 16 * ks + 4 * hh;
                    const v2u lo8 = *(const LAS v2u*)src, hi8 = *(const LAS v2u*)(src + 8);
                    *(v4u*)(QA + ((((size_t)item * 8 + w) * 4 + mt * 2 + ks) * 64 + lane) * 8) = (v4u){lo8.x, lo8.y, hi8.x, hi8.y}; }
        }
        f32x4 lo[2];
#pragma unroll
        for (int e = 0; e < 2; ++e) { const int blk = 2 * F.wave + e, bi = blk >> 2, bj = blk & 3; f32x4 a = (f32x4){0.f, 0.f, 0.f, 0.f};
#pragma unroll
            for (int kk = 0; kk < 8; ++kk) { const s16x8 av = *(const LAS s16x8*)(QX + (16 * bi + r16) * 264 + 32 * kk + 8 * q4), bv = *(const LAS s16x8*)(KX + (16 * bj + r16) * 264 + 32 * kk + 8 * q4);
                a = __builtin_amdgcn_mfma_f32_16x16x32_bf16(av, bv, a, 0, 0, 0); }
            lo[e] = a; }
        __syncthreads();
#pragma unroll
        for (int ii = 0; ii < 32; ++ii) { const int i = half * 32 + ii; const float Lv = Lc[i * 257 + d] + off; const float qv = __uint_as_float(qraw[ii] << 16), kv = __uint_as_float(kraw[ii] << 16);
            const float ea = __expf(Lv), eb = __expf(-Lv);
            QX[i * 264 + d] = (bf16)f2bf(qv * 0.0625f * eb); KX[i * 264 + d] = (bf16)f2bf(kv * ea); }
        __syncthreads();
#pragma unroll
        for (int e = 0; e < 2; ++e) { const int blk = 2 * F.wave + e, bi = blk >> 2, bj = blk & 3; f32x4 a = (f32x4){0.f, 0.f, 0.f, 0.f};
#pragma unroll
            for (int kk = 0; kk < 8; ++kk) { const s16x8 av = *(const LAS s16x8*)(QX + (16 * bi + r16) * 264 + 32 * kk + 8 * q4), bv = *(const LAS s16x8*)(KX + (16 * bj + r16) * 264 + 32 * kk + 8 * q4);
                a = __builtin_amdgcn_mfma_f32_16x16x32_bf16(av, bv, a, 0, 0, 0); }
            const int j = 16 * bj + r16;
#pragma unroll
            for (int reg = 0; reg < 4; ++reg) { const int i = 16 * bi + 4 * q4 + reg; SC[((((size_t)item * 4 + (j >> 4)) * 2 + (i >> 5)) * 64 + 32 * ((j >> 3) & 1) + (i & 31)) * 8 + (j & 7)] = (bf16)f2bf((i >= j) ? lo[e][reg] : a[reg]); } }
        __syncthreads();
    }
}
#define GLD16(dst, ptr, off) asm volatile("global_load_dwordx4 %0, %1, off offset:" #off : "=v"(dst) : "v"(ptr) : "memory")
struct ScanMain { v4u qa[2][2], p[2], vtp; };
struct ScanLate { v4u kd[4], vt[4], gm[4]; };
__device__ __forceinline__ void scan_issue_main(ScanMain& o, const bf16* QA, const bf16* VT, const bf16* SC, int b, int h, int sl, int n, int w, int lane) {
    const size_t item = ((size_t)b * NCHUNK + n) * GH + h; const size_t chunk = (size_t)b * NCHUNK + n;
    const bf16* q0 = QA + ((item * 8 + w) * 4) * 512 + lane * 8;
    const bf16* vp2 = VT + ((((chunk * GH + h) * 16 + sl) * 4 + (w & 3)) * 64 + lane) * 8;
    const bf16* p0 = SC + ((item * 4 + (w & 3)) * 2) * 512 + lane * 8;
    GLD16(o.qa[0][0], q0, 0); GLD16(o.qa[0][1], q0, 1024); GLD16(o.qa[1][0], q0, 2048); GLD16(o.qa[1][1], q0, 3072);
    GLD16(o.p[0], p0, 0); GLD16(o.p[1], p0, 1024); GLD16(o.vtp, vp2, 0);
}
__device__ __forceinline__ void scan_issue_late(ScanLate& o, const bf16* KDT, const bf16* VT, const float* GAM, int b, int h, int sl, int n, int w, int lane) {
    const size_t item = ((size_t)b * NCHUNK + n) * GH + h; const size_t chunk = (size_t)b * NCHUNK + n;
    const bf16* kp = KDT + ((item * 8 + w) * 4) * 512 + lane * 8;
    const bf16* vp = VT + ((((chunk * GH + h) * 16 + sl) * 4) * 64 + lane) * 8;
    const float* gp = GAM + item * HK + 32 * w + 4 * (lane >> 5);
    GLD16(o.kd[0], kp, 0); GLD16(o.kd[1], kp, 1024); GLD16(o.kd[2], kp, 2048); GLD16(o.kd[3], kp, 3072);
    GLD16(o.vt[0], vp, 0); GLD16(o.vt[1], vp, 1024); GLD16(o.vt[2], vp, 2048); GLD16(o.vt[3], vp, 3072);
    GLD16(o.gm[0], gp, 0); GLD16(o.gm[1], gp, 32); GLD16(o.gm[2], gp, 64); GLD16(o.gm[3], gp, 96);
}
#define SCAN_WAIT_MAIN(o) asm volatile("s_waitcnt vmcnt(19)" : "+v"(o.qa[0][0]), "+v"(o.qa[0][1]), "+v"(o.qa[1][0]), "+v"(o.qa[1][1]), "+v"(o.p[0]), "+v"(o.p[1]), "+v"(o.vtp) :: "memory")
#define SCAN_WAIT_LATE(o) asm volatile("s_waitcnt vmcnt(7)" : "+v"(o.kd[0]), "+v"(o.kd[1]), "+v"(o.kd[2]), "+v"(o.kd[3]), "+v"(o.vt[0]), "+v"(o.vt[1]), "+v"(o.vt[2]), "+v"(o.vt[3]), \
    "+v"(o.gm[0]), "+v"(o.gm[1]), "+v"(o.gm[2]), "+v"(o.gm[3]) :: "memory")
#define SCAN_DRAIN_MAIN(o) asm volatile("s_waitcnt vmcnt(0)" : "+v"(o.qa[0][0]), "+v"(o.qa[0][1]), "+v"(o.qa[1][0]), "+v"(o.qa[1][1]), "+v"(o.p[0]), "+v"(o.p[1]), "+v"(o.vtp) :: "memory")
#define SCAN_DRAIN_LATE(o) asm volatile("s_waitcnt vmcnt(0)" : "+v"(o.kd[0]), "+v"(o.kd[1]), "+v"(o.kd[2]), "+v"(o.kd[3]), "+v"(o.vt[0]), "+v"(o.vt[1]), "+v"(o.vt[2]), "+v"(o.vt[3]), \
    "+v"(o.gm[0]), "+v"(o.gm[1]), "+v"(o.gm[2]), "+v"(o.gm[3]) :: "memory")
__device__ __forceinline__ void scan_out(const ScanMain& c, const f32x16& S, LAS float* buf, int w, int r, int hh) {
    f32x16 op[2];
#pragma unroll
    for (int mt = 0; mt < 2; ++mt)
#pragma unroll
        for (int i = 0; i < 16; ++i) op[mt][i] = 0.f;
    if (w < 4) {
#pragma unroll
        for (int mt = 0; mt < 2; ++mt) op[mt] = __builtin_amdgcn_mfma_f32_32x32x16_bf16(__builtin_bit_cast(s16x8, c.p[mt]), __builtin_bit_cast(s16x8, c.vtp), op[mt], 0, 0, 0); }
    const s16x8 sb0 = __builtin_bit_cast(s16x8, (v4u){cvtpk(S[0], S[1]), cvtpk(S[2], S[3]), cvtpk(S[4], S[5]), cvtpk(S[6], S[7])});
    const s16x8 sb1 = __builtin_bit_cast(s16x8, (v4u){cvtpk(S[8], S[9]), cvtpk(S[10], S[11]), cvtpk(S[12], S[13]), cvtpk(S[14], S[15])});
#pragma unroll
    for (int mt = 0; mt < 2; ++mt) { op[mt] = __builtin_amdgcn_mfma_f32_32x32x16_bf16(__builtin_bit_cast(s16x8, c.qa[mt][0]), sb0, op[mt], 0, 0, 0);
        op[mt] = __builtin_amdgcn_mfma_f32_32x32x16_bf16(__builtin_bit_cast(s16x8, c.qa[mt][1]), sb1, op[mt], 0, 0, 0); }
#pragma unroll
    for (int mt = 0; mt < 2; ++mt)
#pragma unroll
        for (int i = 0; i < 16; ++i) buf[w * 2048 + (32 * mt + crow32(i, hh)) * 32 + r] = op[mt][i];
}
__device__ __forceinline__ void scan_state(const ScanLate& c, f32x16& S) {
#pragma unroll
    for (int i = 0; i < 16; ++i) S[i] *= __uint_as_float(c.gm[i >> 2][i & 3]);
#pragma unroll
    for (int kk = 0; kk < 4; ++kk) S = __builtin_amdgcn_mfma_f32_32x32x16_bf16(__builtin_bit_cast(s16x8, c.kd[kk]), __builtin_bit_cast(s16x8, c.vt[kk]), S, 0, 0, 0);
}
__device__ __forceinline__ void scan_reduce(const LAS float* buf, float* OG, int r0, int h, int sl, int tid) {
    const int tok = tid >> 3, v4 = (tid & 7) * 4; const LAS float* p = buf + tok * 32 + v4;
    f32x4 a = *(const LAS f32x4*)p + *(const LAS f32x4*)(p + 2048);
    a += *(const LAS f32x4*)(p + 2 * 2048) + *(const LAS f32x4*)(p + 3 * 2048);
    a += *(const LAS f32x4*)(p + 4 * 2048) + *(const LAS f32x4*)(p + 5 * 2048);
    a += *(const LAS f32x4*)(p + 6 * 2048) + *(const LAS f32x4*)(p + 7 * 2048);
    *(f32x4*)(OG + (size_t)(r0 + tok) * DGV + h * HV + sl * 32 + v4) = a;
}
__device__ __forceinline__ void gla_scan(Frame& F, const bf16* QA, const bf16* KDT, const bf16* VT, const bf16* SC, const float* GAM, float* OG) {
    LAS float* RB = (LAS float*)(F.lds);
    const int tid = F.tid, lane = F.lane, w = F.wave, r = lane & 31, hh = lane >> 5;
    for (int unit = blockIdx.x; unit < BATCH * GH * 16; unit += F.G) {
        const int sl = unit & 15, h = (unit >> 4) % GH, b = unit / (16 * GH);
        f32x16 S;
#pragma unroll
        for (int i = 0; i < 16; ++i) S[i] = 0.f;
        ScanMain A, B; ScanLate L;
        VM_WAIT();
        scan_issue_main(A, QA, VT, SC, b, h, sl, 0, w, lane);
        scan_issue_late(L, KDT, VT, GAM, b, h, sl, 0, w, lane);
#pragma unroll 1
        for (int n = 0; n < NCHUNK; n += 2) {
            scan_issue_main(B, QA, VT, SC, b, h, sl, n + 1, w, lane);
            SCAN_WAIT_MAIN(A);
            scan_out(A, S, RB, w, r, hh);
            SCAN_WAIT_LATE(L);
            scan_state(L, S);
            scan_issue_late(L, KDT, VT, GAM, b, h, sl, n + 1, w, lane);
            asm volatile("s_waitcnt lgkmcnt(0)" ::: "memory"); __builtin_amdgcn_s_barrier(); asm volatile("" ::: "memory");
            scan_reduce(RB, OG, b * SEQ + n * CHUNK, h, sl, tid);
            scan_issue_main(A, QA, VT, SC, b, h, sl, (n + 2 < NCHUNK) ? n + 2 : n, w, lane);
            SCAN_WAIT_MAIN(B);
            scan_out(B, S, RB + 16384, w, r, hh);
            SCAN_WAIT_LATE(L);
            scan_state(L, S);
            scan_issue_late(L, KDT, VT, GAM, b, h, sl, (n + 2 < NCHUNK) ? n + 2 : n, w, lane);
            asm volatile("s_waitcnt lgkmcnt(0)" ::: "memory"); __builtin_amdgcn_s_barrier(); asm volatile("" ::: "memory");
            scan_reduce(RB + 16384, OG, b * SEQ + (n + 1) * CHUNK, h, sl, tid);
        }
        SCAN_DRAIN_MAIN(A); SCAN_DRAIN_MAIN(B); SCAN_DRAIN_LATE(L);
        __syncthreads();
    }
}
struct ScanMain2 { v4u qa[2][2], p[2], vtp[2]; };
struct ScanLate2 { v4u kd[4], vt[2][4], gm[4]; };
#define GLD16S(dst, sbase, voff, off) asm volatile("global_load_dwordx4 %0, %1, %2 offset:" #off : "=v"(dst) : "v"(voff), "s"(sbase) : "memory")
__device__ __forceinline__ void scan2_issue_main(ScanMain2& o, const bf16* QA, const bf16* VT, const bf16* SC, int b, int h, int sp, int n, int w, unsigned lo16) {
    const size_t item = ((size_t)b * NCHUNK + n) * GH + h;
    const bf16* q0 = QA + ((item * 8 + w) * 4) * 512;
    const bf16* v0 = VT + (((item * 16 + 2 * sp) * 4 + (w & 3)) * 64) * 8; const bf16* v1 = v0 + 2048;
    const bf16* p0 = SC + ((item * 4 + (w & 3)) * 2) * 512;
    GLD16S(o.qa[0][0], q0, lo16, 0); GLD16S(o.qa[0][1], q0, lo16, 1024); GLD16S(o.qa[1][0], q0, lo16, 2048); GLD16S(o.qa[1][1], q0, lo16, 3072);
    GLD16S(o.p[0], p0, lo16, 0); GLD16S(o.p[1], p0, lo16, 1024); GLD16S(o.vtp[0], v0, lo16, 0); GLD16S(o.vtp[1], v1, lo16, 0);
}
__device__ __forceinline__ void scan2_issue_late(ScanLate2& o, const bf16* KDT, const bf16* VT, const float* GAM, int b, int h, int sp, int n, int w, unsigned lo16, unsigned go16) {
    const size_t item = ((size_t)b * NCHUNK + n) * GH + h;
    const bf16* kp = KDT + ((item * 8 + w) * 4) * 512;
    const bf16* v0 = VT + (((item * 16 + 2 * sp) * 4) * 64) * 8; const bf16* v1 = v0 + 2048;
    const float* gp = GAM + item * HK + 32 * w;
    GLD16S(o.kd[0], kp, lo16, 0); GLD16S(o.kd[1], kp, lo16, 1024); GLD16S(o.kd[2], kp, lo16, 2048); GLD16S(o.kd[3], kp, lo16, 3072);
    GLD16S(o.vt[0][0], v0, lo16, 0); GLD16S(o.vt[0][1], v0, lo16, 1024); GLD16S(o.vt[0][2], v0, lo16, 2048); GLD16S(o.vt[0][3], v0, lo16, 3072);
    GLD16S(o.vt[1][0], v1, lo16, 0); GLD16S(o.vt[1][1], v1, lo16, 1024); GLD16S(o.vt[1][2], v1, lo16, 2048); GLD16S(o.vt[1][3], v1, lo16, 3072);
    GLD16S(o.gm[0], gp, go16, 0); GLD16S(o.gm[1], gp, go16, 32); GLD16S(o.gm[2], gp, go16, 64); GLD16S(o.gm[3], gp, go16, 96);
}
#define SCAN2_MAIN_REGS(o) "+v"(o.qa[0][0]), "+v"(o.qa[0][1]), "+v"(o.qa[1][0]), "+v"(o.qa[1][1]), "+v"(o.p[0]), "+v"(o.p[1]), "+v"(o.vtp[0]), "+v"(o.vtp[1])
#define SCAN2_LATE_REGS(o) "+v"(o.kd[0]), "+v"(o.kd[1]), "+v"(o.kd[2]), "+v"(o.kd[3]), "+v"(o.vt[0][0]), "+v"(o.vt[0][1]), "+v"(o.vt[0][2]), "+v"(o.vt[0][3]), \
    "+v"(o.vt[1][0]), "+v"(o.vt[1][1]), "+v"(o.vt[1][2]), "+v"(o.vt[1][3]), "+v"(o.gm[0]), "+v"(o.gm[1]), "+v"(o.gm[2]), "+v"(o.gm[3])
#define SCAN2_WAIT_MAIN(o) asm volatile("s_waitcnt vmcnt(24)" : SCAN2_MAIN_REGS(o) :: "memory")
#define SCAN2_WAIT_LATE(o) asm volatile("s_waitcnt vmcnt(8)" : SCAN2_LATE_REGS(o) :: "memory")
#define SCAN2_DRAIN_MAIN(o) asm volatile("s_waitcnt vmcnt(0)" : SCAN2_MAIN_REGS(o) :: "memory")
#define SCAN2_DRAIN_LATE(o) asm volatile("s_waitcnt vmcnt(0)" : SCAN2_LATE_REGS(o) :: "memory")
__device__ __forceinline__ void scan2_out(const v4u (&qa)[2][2], const v4u (&p)[2], const v4u& vtp, const f32x16& S, LAS float* buf, int w, int r, int hh) {
    f32x16 op[2];
#pragma unroll
    for (int mt = 0; mt < 2; ++mt)
#pragma unroll
        for (int i = 0; i < 16; ++i) op[mt][i] = 0.f;
    if (w < 4) {
#pragma unroll
        for (int mt = 0; mt < 2; ++mt) op[mt] = __builtin_amdgcn_mfma_f32_32x32x16_bf16(__builtin_bit_cast(s16x8, p[mt]), __builtin_bit_cast(s16x8, vtp), op[mt], 0, 0, 0); }
    const s16x8 sb0 = __builtin_bit_cast(s16x8, (v4u){cvtpk(S[0], S[1]), cvtpk(S[2], S[3]), cvtpk(S[4], S[5]), cvtpk(S[6], S[7])});
    const s16x8 sb1 = __builtin_bit_cast(s16x8, (v4u){cvtpk(S[8], S[9]), cvtpk(S[10], S[11]), cvtpk(S[12], S[13]), cvtpk(S[14], S[15])});
#pragma unroll
    for (int mt = 0; mt < 2; ++mt) { op[mt] = __builtin_amdgcn_mfma_f32_32x32x16_bf16(__builtin_bit_cast(s16x8, qa[mt][0]), sb0, op[mt], 0, 0, 0);
        op[mt] = __builtin_amdgcn_mfma_f32_32x32x16_bf16(__builtin_bit_cast(s16x8, qa[mt][1]), sb1, op[mt], 0, 0, 0); }
#pragma unroll
    for (int mt = 0; mt < 2; ++mt)
#pragma unroll
        for (int i = 0; i < 16; ++i) buf[w * 2048 + (32 * mt + crow32(i, hh)) * 32 + r] = op[mt][i];
}
__device__ __forceinline__ void scan2_state(const v4u (&kd)[4], const v4u (&vt)[4], const v4u (&gm)[4], f32x16& S) {
#pragma unroll
    for (int i = 0; i < 16; ++i) S[i] *= __uint_as_float(gm[i >> 2][i & 3]);
#pragma unroll
    for (int kk = 0; kk < 4; ++kk) S = __builtin_amdgcn_mfma_f32_32x32x16_bf16(__builtin_bit_cast(s16x8, kd[kk]), __builtin_bit_cast(s16x8, vt[kk]), S, 0, 0, 0);
}
#define SCAN2_BAR() do { asm volatile("s_waitcnt lgkmcnt(0)" ::: "memory"); __builtin_amdgcn_s_barrier(); asm volatile("" ::: "memory"); } while (0)
__device__ __forceinline__ void gla_scan2(Frame& F, int unit, const bf16* QA, const bf16* KDT, const bf16* VT, const bf16* SC, const float* GAM, float* OG) {
    LAS float* RB = (LAS float*)(F.lds);
    const int tid = F.tid, lane = F.lane, w = F.wave, r = lane & 31, hh = lane >> 5;
    const int bh = (unit & 7) * 2 + (unit >> 6), sp = (unit >> 3) & 7, b = bh >> 2, h = bh & 3;
    const unsigned lo16 = (unsigned)lane * 16u, go16 = (unsigned)(lane >> 5) * 16u;
    f32x16 S0, S1;
#pragma unroll
    for (int i = 0; i < 16; ++i) { S0[i] = 0.f; S1[i] = 0.f; }
    ScanMain2 A, B; ScanLate2 L;
    VM_WAIT();
    scan2_issue_main(A, QA, VT, SC, b, h, sp, 0, w, lo16);
    scan2_issue_late(L, KDT, VT, GAM, b, h, sp, 0, w, lo16, go16);
#pragma unroll 1
    for (int n = 0; n < NCHUNK; n += 2) {
        scan2_issue_main(B, QA, VT, SC, b, h, sp, n + 1, w, lo16);
        SCAN2_WAIT_MAIN(A);
        scan2_out(A.qa, A.p, A.vtp[0], S0, RB, w, r, hh); asm volatile("" ::: "memory"); scan2_out(A.qa, A.p, A.vtp[1], S1, RB + 16384, w, r, hh);
        SCAN2_WAIT_LATE(L);
        scan2_state(L.kd, L.vt[0], L.gm, S0); scan2_state(L.kd, L.vt[1], L.gm, S1);
        scan2_issue_late(L, KDT, VT, GAM, b, h, sp, n + 1, w, lo16, go16);
        SCAN2_BAR();
        scan_reduce(RB, OG, b * SEQ + n * CHUNK, h, 2 * sp, tid); asm volatile("" ::: "memory"); scan_reduce(RB + 16384, OG, b * SEQ + n * CHUNK, h, 2 * sp + 1, tid);
        SCAN2_BAR();
        scan2_issue_main(A, QA, VT, SC, b, h, sp, (n + 2 < NCHUNK) ? n + 2 : n, w, lo16);
        SCAN2_WAIT_MAIN(B);
        scan2_out(B.qa, B.p, B.vtp[0], S0, RB, w, r, hh); asm volatile("" ::: "memory"); scan2_out(B.qa, B.p, B.vtp[1], S1, RB + 16384, w, r, hh);
        SCAN2_WAIT_LATE(L);
        scan2_state(L.kd, L.vt[0], L.gm, S0); scan2_state(L.kd, L.vt[1], L.gm, S1);
        scan2_issue_late(L, KDT, VT, GAM, b, h, sp, (n + 2 < NCHUNK) ? n + 2 : n, w, lo16, go16);
        SCAN2_BAR();
        scan_reduce(RB, OG, b * SEQ + (n + 1) * CHUNK, h, 2 * sp, tid); asm volatile("" ::: "memory"); scan_reduce(RB + 16384, OG, b * SEQ + (n + 1) * CHUNK, h, 2 * sp + 1, tid);
        SCAN2_BAR();
    }
    SCAN2_DRAIN_MAIN(A); SCAN2_DRAIN_MAIN(B); SCAN2_DRAIN_LATE(L);
    __syncthreads();
}
__device__ __forceinline__ void gla_post(Frame& F, const float* OG, const bf16* PROJ, const float* gng, bf16* OP) {
    const int gw = F.vcu * NWAVES + F.wave, NGW = F.G * NWAVES;
    const f32x4 g0 = *(const f32x4*)(gng + 8 * F.lane), g1 = *(const f32x4*)(gng + 8 * F.lane + 4);
    for (int task = gw; task < M * GH; task += NGW) { const int t = task / GH, h = task % GH;
        const float* op = OG + (size_t)t * DGV + h * HV + 8 * F.lane;
        const f32x4 a = *(const f32x4*)op, c = *(const f32x4*)(op + 4);
        const float ss = (a.x * a.x + a.y * a.y) + (a.z * a.z + a.w * a.w) + (c.x * c.x + c.y * c.y) + (c.z * c.z + c.w * c.w);
        const float rstd = 1.0f / sqrtf(wave_sum(ss) * (1.0f / HV) + EPS);
        const v4u rv = *(const v4u*)(PROJ + (size_t)t * LDP + PC_R + h * HV + 8 * F.lane);
        const float r[8] = {bflo(rv.x), bfhi(rv.x), bflo(rv.y), bfhi(rv.y), bflo(rv.z), bfhi(rv.z), bflo(rv.w), bfhi(rv.w)};
        float o[8] = {a.x * rstd * g0.x, a.y * rstd * g0.y, a.z * rstd * g0.z, a.w * rstd * g0.w, c.x * rstd * g1.x, c.y * rstd * g1.y, c.z * rstd * g1.z, c.w * rstd * g1.w};
#pragma unroll
        for (int e = 0; e < 8; ++e) o[e] *= pg8::silu_f(r[e]);
        v4u w; w.x = pk2(o[0], o[1]); w.y = pk2(o[2], o[3]); w.z = pk2(o[4], o[5]); w.w = pk2(o[6], o[7]);
        *(v4u*)(OP + (size_t)t * (DCONV + DGV) + DCONV + h * HV + 8 * F.lane) = w; }
}

__device__ __forceinline__ void alow_phase(Frame& F, const bf16* XB, const bf16* WA, const float* SSQ, float* AL32) {
    LAS float* red = (LAS float*)(F.lds);
    const int lane = F.lane, r16 = lane & 15, q4 = lane >> 4, w = F.wave, rb = w & 1, kq = w >> 1;
    for (int vb = blockIdx.x; vb < M / 32; vb += F.G) {
        const bf16* ap = XB + (size_t)(32 * vb + 16 * rb + r16) * DM + 1024 * kq + 8 * q4;
        const bf16* bp = WA + (size_t)r16 * DM + 1024 * kq + 8 * q4;
        f32x4 acc = (f32x4){0.f, 0.f, 0.f, 0.f};
#pragma unroll 8
        for (int kk = 0; kk < 32; ++kk) { const s16x8 av = __builtin_bit_cast(s16x8, *(const v4u*)(ap + 32 * kk)), bv = __builtin_bit_cast(s16x8, *(const v4u*)(bp + 32 * kk));
            acc = __builtin_amdgcn_mfma_f32_16x16x32_bf16(av, bv, acc, 0, 0, 0); }
#pragma unroll
        for (int reg = 0; reg < 4; ++reg) red[w * 256 + (4 * q4 + reg) * 16 + r16] = acc[reg];
        __syncthreads();
        { const int t = F.tid, row32 = t >> 4, j = t & 15, rbb = row32 >> 4, i = row32 & 15;
          const float s = (red[(rbb + 0) * 256 + i * 16 + j] + red[(rbb + 2) * 256 + i * 16 + j]) + (red[(rbb + 4) * 256 + i * 16 + j] + red[(rbb + 6) * 256 + i * 16 + j]);
          const f32x4 p = *(const f32x4*)(SSQ + (size_t)(32 * vb + row32) * 64 + 4 * j); float ss = (p.x + p.y) + (p.z + p.w);
          ss += __shfl_xor(ss, 1); ss += __shfl_xor(ss, 2); ss += __shfl_xor(ss, 4); ss += __shfl_xor(ss, 8);
          AL32[(size_t)(32 * vb + row32) * 16 + j] = s * (1.0f / sqrtf(ss * (1.0f / DM) + EPS)); }
        __syncthreads();
    }
}

struct Args { const float* in[21]; float* out; unsigned char* ws; int ph_lo, ph_hi; };
__global__ void __launch_bounds__(NWAVES * 64, 2) fwd(Args args) {
    extern __shared__ __attribute__((aligned(16))) unsigned char lds[];
    Frame F;
    F.lds = (LAS unsigned char*)lds;
    F.MISC = (volatile LAS unsigned*)(F.lds + MISC_OFF);
    F.tid = threadIdx.x; F.lane = F.tid & 63; F.wave = __builtin_amdgcn_readfirstlane(F.tid >> 6);
    F.G = gridDim.x; { const int bx = blockIdx.x; F.vcu = (F.G % 8 == 0) ? (bx % 8) * (F.G / 8) + bx / 8 : bx; }
    unsigned char* ws = args.ws;
    F.ctl = (gu32*)(ws + WS_CTL);
    for (int u = F.tid; u < 64; u += NWAVES * 64) ((LAS unsigned*)(F.lds + MISC_OFF))[u] = 0u;
    __syncthreads();
    const int lo = args.ph_lo, hi = args.ph_hi;
    XcdBarrier bar; bar.bar = (unsigned*)(F.ctl + CW_BAR); bar.x = 0; bar.st = nullptr;
    if (hi - lo > 1) bar = xcd_barrier_post((unsigned*)(F.ctl + CW_BAR), F.MISC + 8);
#define IN(k) (lo <= (k) && (k) < hi)
#define SEAM(k) do { if (IN(k) && IN((k) + 1)) xcd_barrier(bar); } while (0)

    const float* x = args.in[0]; float* out = args.out;
    const bool scanc = SCAN_SPLIT && F.G == 256;
    const bool tailc = TAIL_CONV && F.G > TAIL_W0;
    bf16* Wgu1 = (bf16*)(ws + WS_WGU1); bf16* Wd1 = (bf16*)(ws + WS_WD1); bf16* Win = (bf16*)(ws + WS_WIN); bf16* Wco = (bf16*)(ws + WS_WCO);
    bf16* Wmo = (bf16*)(ws + WS_WMO); bf16* Wgu2 = (bf16*)(ws + WS_WGU2); bf16* Wd2 = (bf16*)(ws + WS_WD2);
    bf16* H = (bf16*)(ws + WS_H); bf16* ACT = (bf16*)(ws + WS_ACT); bf16* PROJ = (bf16*)(ws + WS_ACT);
    bf16* SC = (bf16*)(ws + WS_SC); float* OG = (float*)(ws + WS_OG); bf16* OP = (bf16*)(ws + WS_OP); bf16* CA = (bf16*)(ws + WS_OP);
    bf16* MG = (bf16*)(ws + WS_MG);
    bf16* QA = (bf16*)(ws + WS_QA); bf16* KDT = (bf16*)(ws + WS_KDT); bf16* VT = (bf16*)(ws + WS_VT); float* GAM = (float*)(ws + WS_GAM);
    float* SSQ = (float*)(ws + WS_SSQ); float* AL32 = (float*)(ws + WS_AL); bf16* WA = (bf16*)(ws + WS_WA);

    if (IN(0)) {
        LAS float* scr = (LAS float*)(F.lds + F.wave * 16640);
        conv_seg(F, args.in[2], DFF, DM, 0, DFF / 64, 64, 64, Wgu1, 1, 256, 0, scr);
        conv_seg(F, args.in[3], DFF, DM, 0, DFF / 64, 64, 64, Wgu1, 1, 256, 128, scr);
        conv_seg(F, args.in[4], DM, DFF, 0, DM / 64, 64, 64, Wd1, 0, 64, 0, scr);
        conv_seg(F, args.in[6], DIN_SRC, DM, 0, 12288 / 64, 64, 64, Win, 0, 64, 0, scr);
        conv_seg(F, args.in[6], DIN_SRC, DM, 12304, 8192 / 64, 64, 64, Win, 0, 64, PC_GA, scr);
        conv_seg(F, args.in[6], DIN_SRC, DM, 12288, 1, 16, 16, WA, 0, 64, 0, scr);
        if (!tailc) {
        conv_seg(F, args.in[9], DM, DCONV, 0, DM / 64, 64, 64, Wco, 0, 64, 0, scr, nullptr, -1, 0, DCONV + DGV, 0);
        conv_seg(F, args.in[13], DM, DGV, 0, DM / 64, 64, 64, Wco, 0, 64, 0, scr, nullptr, -1, 0, DCONV + DGV, DCONV);
        conv_seg(F, args.in[15], DM, DM, 0, DM / 64, 64, 64, Wmo, 0, 64, 0, scr); }
        if (!scanc) conv_seg(F, args.in[17], DFF, DM, 0, DFF / 64, 64, 64, Wgu2, 1, 256, 0, scr);
        conv_seg(F, args.in[18], DFF, DM, scanc ? SCAN_UP_BLK * 64 : 0, DFF / 64 - (scanc ? SCAN_UP_BLK : 0), 64, 64, Wgu2, 1, 256, 128 + (scanc ? (SCAN_UP_BLK >> 1) * 256 : 0), scr);
        if (!tailc) conv_seg(F, args.in[19], DM, DFF, 0, DM / 64, 64, 64, Wd2, 0, 64, 0, scr);
        rms_rows_bf16(F, x, args.in[1], H);
    }
    SEAM(0);
    if (IN(1)) { pg8::Gemm g{H, Wgu1, M, 2 * DFF, DM}; pg8::StaticOrder S; S.init(M, 2 * DFF, F.G, (int)blockIdx.x);
        pg8::EpiSwiGLU E{ACT, DFF};
        pg8::gemm_phase<pg8::EpiSwiGLU, pg8::StaticOrder, false, true>(F.lds + RING_OFF, g, S, E);
        if (tailc && (int)blockIdx.x >= TAIL_W0) {
            LAS float* scr = (LAS float*)(F.lds + F.wave * 16640); const int gw = ((int)blockIdx.x - TAIL_W0) * NWAVES + F.wave, ngw = (F.G - TAIL_W0) * NWAVES;
            conv_seg_pipe(F, args.in[9], DM, DCONV, 0, DM / 64, 64, 64, Wco, 0, 64, 0, scr, nullptr, gw, ngw, DCONV + DGV, 0);
            conv_seg_pipe(F, args.in[13], DM, DGV, 0, DM / 64, 64, 64, Wco, 0, 64, 0, scr, nullptr, gw, ngw, DCONV + DGV, DCONV);
            conv_seg_pipe(F, args.in[15], DM, DM, 0, DM / 64, 64, 64, Wmo, 0, 64, 0, scr, nullptr, gw, ngw);
            } }
    SEAM(1);
    if (IN(2)) { pg8::Gemm g{ACT, Wd1, M, DM, DFF}; pg8::StaticOrder S; S.init(M, DM, F.G, (int)blockIdx.x);
        pg8::EpiResidStats E{x, out, DM, 0.5f, H, SSQ, args.in[5]};
        pg8::gemm_phase<pg8::EpiResidStats, pg8::StaticOrder, true, true>(F.lds + RING_OFF, g, S, E); }
    SEAM(2);
    if (IN(3)) { pg8::Gemm g{H, Win, M, LDP, DM}; pg8::RstdOrder S; S.init(M, LDP, F.G, (int)blockIdx.x); S.init_r(SSQ, (LAS float*)(F.lds + RTAB_OFF), 1.0f / DM, EPS);
        pg8::EpiBf16R E{PROJ, LDP, &S};
        pg8::gemm_phase<pg8::EpiBf16R, pg8::RstdOrder, false, true>(F.lds + RING_OFF, g, S, E);
        alow_phase(F, H, WA, SSQ, AL32); }
    SEAM(3);
    if (IN(4)) { vt_transpose(F, PROJ, VT); __syncthreads(); gla_prep(F, PROJ, AL32, args.in[10], args.in[11], SC, QA, KDT, GAM); conv_branch(F, PROJ, args.in[7], args.in[8], CA); }
    SEAM(4);
    if (IN(5)) {
        if (scanc) {
            if ((int)blockIdx.x < 128) gla_scan2(F, (int)blockIdx.x, QA, KDT, VT, SC, GAM, OG);
            else { LAS float* scr = (LAS float*)(F.lds + F.wave * 16640); const int gw = ((int)blockIdx.x - 128) * NWAVES + F.wave, ngw = 128 * NWAVES;
                conv_seg_pipe(F, args.in[17], DFF, DM, 0, DFF / 64, 64, 64, Wgu2, 1, 256, 0, scr, nullptr, gw, ngw);
                if (SCAN_UP_BLK) conv_seg_pipe(F, args.in[18], DFF, DM, 0, SCAN_UP_BLK, 64, 64, Wgu2, 1, 256, 128, scr, nullptr, gw, ngw); }
        } else gla_scan(F, QA, KDT, VT, SC, GAM, OG);
    }
    SEAM(5);
    if (IN(6)) gla_post(F, OG, PROJ, args.in[12], OP);
    SEAM(6);
    if (IN(7)) { pg8::Gemm g{OP, Wco, M, DM, DCONV + DGV}; pg8::StaticOrder S; S.init(M, DM, F.G, (int)blockIdx.x);
        pg8::EpiGateMerge E{PROJ + PC_GA, PROJ + PC_GB, LDP, args.in[14], DM, MG, DM};
        pg8::gemm_phase<pg8::EpiGateMerge, pg8::StaticOrder, true, true>(F.lds + RING_OFF, g, S, E); }
    SEAM(7);
    if (IN(8)) { pg8::Gemm g{MG, Wmo, M, DM, DM}; pg8::StaticOrder S; S.init(M, DM, F.G, (int)blockIdx.x);
        pg8::EpiResidStats E{out, out, DM, 1.0f, H, SSQ, args.in[16]};
        pg8::gemm_phase<pg8::EpiResidStats, pg8::StaticOrder, true, true>(F.lds + RING_OFF, g, S, E); }
    SEAM(8);
    if (IN(9)) { pg8::Gemm g{H, Wgu2, M, 2 * DFF, DM}; pg8::RstdOrder S; S.init(M, 2 * DFF, F.G, (int)blockIdx.x); S.init_r(SSQ, (LAS float*)(F.lds + RTAB_OFF), 1.0f / DM, EPS);
        pg8::EpiSwiGLUR E{ACT, DFF, &S};
        pg8::gemm_phase<pg8::EpiSwiGLUR, pg8::RstdOrder, false, true>(F.lds + RING_OFF, g, S, E);
        if (tailc && (int)blockIdx.x >= TAIL_W0) {
            LAS float* scr = (LAS float*)(F.lds + F.wave * 16640); const int gw = ((int)blockIdx.x - TAIL_W0) * NWAVES + F.wave, ngw = (F.G - TAIL_W0) * NWAVES;
            conv_seg_pipe(F, args.in[19], DM, DFF, 0, DM / 64, 64, 64, Wd2, 0, 64, 0, scr, nullptr, gw, ngw); } }
    SEAM(9);
    if (IN(10)) { pg8::Gemm g{ACT, Wd2, M, DM, DFF}; pg8::StaticOrder S; S.init(M, DM, F.G, (int)blockIdx.x);
        pg8::EpiResidBf16 E{out, H, DM, 0.5f};
        pg8::gemm_phase<pg8::EpiResidBf16, pg8::StaticOrder, true, true>(F.lds + RING_OFF, g, S, E); }
    SEAM(10);
    if (IN(11)) rms_rows_final(F, H, out, args.in[20]);
#undef IN
#undef SEAM
}

#ifndef N_LAUNCH_MODE
#define N_LAUNCH_MODE 1
#endif
extern "C" void kernel_launch(void* const* d_in, const int* in_sizes, int n_in, void* d_out, int out_size, void* d_ws, size_t ws_size, hipStream_t stream) {
    static int grid = 0;
    if (grid == 0) {
        if (n_in != 21 || in_sizes[0] != M * DM || out_size != M * DM || ws_size < WS_END) { fprintf(stderr, "kernel_launch: unexpected problem (n_in %d, in0 %d, out %d, ws %zu < %zu)\n", n_in, n_in > 0 ? in_sizes[0] : -1, out_size, ws_size, (size_t)WS_END); grid = -1; return; }
        int dev = 0, cus = 0;
        if (hipGetDevice(&dev) != hipSuccess || hipDeviceGetAttribute(&cus, hipDeviceAttributeMultiprocessorCount, dev) != hipSuccess) { grid = -1; return; }
        if (hipFuncSetAttribute((const void*)fwd, hipFuncAttributeMaxDynamicSharedMemorySize, LDS_BYTES) != hipSuccess) { fprintf(stderr, "kernel_launch: hipFuncSetAttribute failed\n"); grid = -1; return; }
        (void)hipGetLastError();
        grid = cus;
    }
    if (grid < 0) return;
    if (hipMemsetAsync((char*)d_ws + WS_CTL, 0, CTL_ZERO_BYTES, stream) != hipSuccess) return;
    Args a{};
    for (int i = 0; i < 21; ++i) a.in[i] = (const float*)d_in[i];
    a.out = (float*)d_out; a.ws = (unsigned char*)d_ws;
    if (N_LAUNCH_MODE == 1) { a.ph_lo = 0; a.ph_hi = NPHASE; hipLaunchKernelGGL(fwd, dim3(grid), dim3(NWAVES * 64), LDS_BYTES, stream, a); }
    else for (int p = 0; p < NPHASE; ++p) { a.ph_lo = p; a.ph_hi = p + 1; hipLaunchKernelGGL(fwd, dim3(grid), dim3(NWAVES * 64), LDS_BYTES, stream, a); }
}
```

```cpp
#include <hip/hip_runtime.h>
#include <cstdio>
#include <cstdint>
namespace pg8 {
#define PG8_LAS __attribute__((address_space(3)))
typedef unsigned short bf16_t;
typedef short bf16x8 __attribute__((ext_vector_type(8)));
typedef float f32x4 __attribute__((ext_vector_type(4)));
typedef unsigned u32x4 __attribute__((ext_vector_type(4)));
constexpr int BM = 256, BK = 64, HALF = 128, HTB = HALF * BK * 2  , STAGE_BYTES = 8 * HTB, NXCD = 8, WGM = 8;

__host__ __device__ __forceinline__ int lds_byte(int r, int c) { const int st = (r >> 4) * 2 + (c >> 5), rr = r & 15, cc = c & 31, ob = rr * 64 + cc * 2; return st * 1024 + (ob ^ (((ob >> 9) & 1) << 5)); }
__host__ __device__ __forceinline__ void stage_rc(int b, int& R, int& C) { const int st = b / 1024, sb = b % 1024, swz = sb ^ (((sb >> 9) & 1) << 5); R = (st >> 1) * 16 + swz / 64; C = (st & 1) * 32 + (swz % 64) / 2; }
__host__ __device__ __forceinline__ int perm32(int rho) { const int n = rho >> 4, i = rho & 15; return 8 * (i >> 2) + 4 * n + (i & 3); }

struct Unit { int pm, pn; };
struct Gemm { const bf16_t* A; const bf16_t* Bt; int M, N, K; };

struct StaticOrder {
    int nM, nN, nwg, G, c;
    __host__ __device__ void init(int M, int N, int G_, int c_) { nM = M / BM; nN = N / BM; nwg = nM * nN; G = G_; c = c_; }
    __host__ __device__ bool next(int i, Unit& u) const {
        const long L = (long)i * G + c; if (L >= nwg) return false;
        int wgid = (int)L; { const int q = nwg / NXCD, r = nwg % NXCD, xcd = wgid % NXCD, off = wgid / NXCD; wgid = (xcd < r ? xcd * (q + 1) : r * (q + 1) + (xcd - r) * q) + off; }
        const int nig = WGM * nN, gid = wgid / nig, fm = gid * WGM, gsz = (nM - fm) < WGM ? (nM - fm) : WGM;
        u.pm = fm + ((wgid % nig) % gsz); u.pn = (wgid % nig) / gsz; return true;
    }
    __device__ __forceinline__ void a_ready(const Unit&) const {}
    __device__ __forceinline__ void done(const Unit&) const {}
};
__device__ __forceinline__ unsigned cvt_pk_bf16(float lo, float hi) { unsigned r; asm volatile("v_cvt_pk_bf16_f32 %0, %1, %2" : "=v"(r) : "v"(lo), "v"(hi)); return r; }
typedef float f32x2 __attribute__((ext_vector_type(2)));
__device__ __forceinline__ float bf_lo(unsigned w) { return __uint_as_float(w << 16); }
__device__ __forceinline__ float bf_hi(unsigned w) { return __uint_as_float(w & 0xffff0000u); }
__device__ __forceinline__ float sigmoid_f(float x) { return __builtin_amdgcn_rcpf(1.0f + __expf(-x)); }
__device__ __forceinline__ float silu_f(float x) { return x * sigmoid_f(x); }

struct EpiSwiGLU {
    static constexpr bool PERM = true, AFTER_DRAIN = false;
    bf16_t* O; int ldc;
    __device__ __forceinline__ void operator()(const f32x4 (&acc)[2][2][4][2], const Unit& u, int wr, int wc, int fr, int fq) const {
        const int row0 = u.pm * BM + wr * 64 + fr, col0 = u.pn * HALF + wc * 32 + 8 * fq;
#pragma unroll
        for (int ai = 0; ai < 2; ++ai)
#pragma unroll
            for (int m = 0; m < 4; ++m) { bf16_t* rowp = O + (size_t)(row0 + ai * HALF + m * 16) * ldc + col0;
                const f32x4 g0 = acc[ai][0][m][0], g1 = acc[ai][0][m][1], u0 = acc[ai][1][m][0], u1 = acc[ai][1][m][1];
                f32x4 v0, v1;
#pragma unroll
                for (int j = 0; j < 4; ++j) { v0[j] = silu_f(g0[j]) * u0[j]; v1[j] = silu_f(g1[j]) * u1[j]; }
                u32x4 w; w.x = cvt_pk_bf16(v0[0], v0[1]); w.y = cvt_pk_bf16(v0[2], v0[3]); w.z = cvt_pk_bf16(v1[0], v1[1]); w.w = cvt_pk_bf16(v1[2], v1[3]);
                *(u32x4*)rowp = w; }
    }
};
struct EpiGateMerge {
    static constexpr bool PERM = true, AFTER_DRAIN = false; static constexpr int MID_T = 32;
    static constexpr float GB_MIN = -60.0f;
    const bf16_t* GA; const bf16_t* GB; int ldg; const float* bias; int nb; bf16_t* O; int ldc;
    __device__ __forceinline__ void mid(f32x4 (&acc)[2][2][4][2], const Unit& u, int wr, int wc, int fr, int fq) const {
        int row0 = u.pm * BM + wr * 64 + fr, col0 = u.pn * BM + wc * 32 + 8 * fq;
        asm volatile("" : "+v"(row0), "+v"(col0));
#pragma unroll
        for (int bj = 0; bj < 2; ++bj) { const f32x4 a0 = *(const f32x4*)(bias + col0 + bj * HALF), a1 = *(const f32x4*)(bias + col0 + bj * HALF + 4), b0 = *(const f32x4*)(bias + nb + col0 + bj * HALF), b1 = *(const f32x4*)(bias + nb + col0 + bj * HALF + 4);
#pragma unroll
            for (int ai = 0; ai < 2; ++ai)
#pragma unroll
                for (int m = 0; m < 4; ++m) { const size_t r = (size_t)(row0 + ai * HALF + m * 16);
                    const u32x4 ga = *(const u32x4*)(GA + r * ldg + col0 + bj * HALF), gb = *(const u32x4*)(GB + r * ldg + col0 + bj * HALF);
                    const float xa[8] = {bf_lo(ga.x) + a0[0], bf_hi(ga.x) + a0[1], bf_lo(ga.y) + a0[2], bf_hi(ga.y) + a0[3], bf_lo(ga.z) + a1[0], bf_hi(ga.z) + a1[1], bf_lo(ga.w) + a1[2], bf_hi(ga.w) + a1[3]};
                    const float xb[8] = {bf_lo(gb.x) + b0[0], bf_hi(gb.x) + b0[1], bf_lo(gb.y) + b0[2], bf_hi(gb.y) + b0[3], bf_lo(gb.z) + b1[0], bf_hi(gb.z) + b1[1], bf_lo(gb.w) + b1[2], bf_hi(gb.w) + b1[3]};
#pragma unroll
                    for (int j = 0; j < 4; ++j) { acc[ai][bj][m][0][j] *= (1.0f + __expf(-fmaxf(xb[j], GB_MIN))) * __builtin_amdgcn_rcpf(1.0f + __expf(-xa[j]));
                        acc[ai][bj][m][1][j] *= (1.0f + __expf(-fmaxf(xb[4 + j], GB_MIN))) * __builtin_amdgcn_rcpf(1.0f + __expf(-xa[4 + j])); }
                    asm volatile("" ::: "memory"); } }
    }
    __device__ __forceinline__ void operator()(const f32x4 (&acc)[2][2][4][2], const Unit& u, int wr, int wc, int fr, int fq) const {
        const int row0 = u.pm * BM + wr * 64 + fr, col0 = u.pn * BM + wc * 32 + 8 * fq;
#pragma unroll
        for (int bj = 0; bj < 2; ++bj) { const f32x4 b0 = *(const f32x4*)(bias + nb + col0 + bj * HALF), b1 = *(const f32x4*)(bias + nb + col0 + bj * HALF + 4);
#pragma unroll
            for (int ai = 0; ai < 2; ++ai)
#pragma unroll
                for (int m = 0; m < 4; ++m) { const size_t r = (size_t)(row0 + ai * HALF + m * 16);
                    const u32x4 g = *(const u32x4*)(GB + r * ldg + col0 + bj * HALF);
                    f32x4 s0, s1;
                    s0[0] = sigmoid_f(fmaxf(bf_lo(g.x) + b0[0], GB_MIN)); s0[1] = sigmoid_f(fmaxf(bf_hi(g.x) + b0[1], GB_MIN)); s0[2] = sigmoid_f(fmaxf(bf_lo(g.y) + b0[2], GB_MIN)); s0[3] = sigmoid_f(fmaxf(bf_hi(g.y) + b0[3], GB_MIN));
                    s1[0] = sigmoid_f(fmaxf(bf_lo(g.z) + b1[0], GB_MIN)); s1[1] = sigmoid_f(fmaxf(bf_hi(g.z) + b1[1], GB_MIN)); s1[2] = sigmoid_f(fmaxf(bf_lo(g.w) + b1[2], GB_MIN)); s1[3] = sigmoid_f(fmaxf(bf_hi(g.w) + b1[3], GB_MIN));
                    const f32x4 v0 = s0 * acc[ai][bj][m][0], v1 = s1 * acc[ai][bj][m][1];
                    u32x4 w; w.x = cvt_pk_bf16(v0[0], v0[1]); w.y = cvt_pk_bf16(v0[2], v0[3]); w.z = cvt_pk_bf16(v1[0], v1[1]); w.w = cvt_pk_bf16(v1[2], v1[3]);
                    *(u32x4*)(O + r * ldc + col0 + bj * HALF) = w; } }
    }
};

struct EpiResidBf16 {
    static constexpr bool PERM = true, AFTER_DRAIN = false;
    const float* base; bf16_t* O; int ldc; float alpha;
    __device__ __forceinline__ void operator()(const f32x4 (&acc)[2][2][4][2], const Unit& u, int wr, int wc, int fr, int fq) const {
        const int row0 = u.pm * BM + wr * 64 + fr, col0 = u.pn * BM + wc * 32 + 8 * fq;
#pragma unroll
        for (int ai = 0; ai < 2; ++ai)
#pragma unroll
            for (int m = 0; m < 4; ++m) { const size_t off = (size_t)(row0 + ai * HALF + m * 16) * ldc + col0;
#pragma unroll
                for (int bj = 0; bj < 2; ++bj) { const f32x4 b0 = *(const f32x4*)(base + off + bj * HALF), b1 = *(const f32x4*)(base + off + bj * HALF + 4);
                    const f32x4 v0 = b0 + acc[ai][bj][m][0] * alpha, v1 = b1 + acc[ai][bj][m][1] * alpha;
                    u32x4 w; w.x = cvt_pk_bf16(v0[0], v0[1]); w.y = cvt_pk_bf16(v0[2], v0[3]); w.z = cvt_pk_bf16(v1[0], v1[1]); w.w = cvt_pk_bf16(v1[2], v1[3]);
                    *(u32x4*)(O + off + bj * HALF) = w; } }
    }
};
struct EpiResidStats {
    static constexpr bool PERM = true, AFTER_DRAIN = false;
    const float* base; float* out; int ldc; float alpha; bf16_t* XB; float* SSQ; const float* gain;
    __device__ __forceinline__ void operator()(const f32x4 (&acc)[2][2][4][2], const Unit& u, int wr, int wc, int fr, int fq) const {
        const int row0 = u.pm * BM + wr * 64 + fr, col0 = u.pn * BM + wc * 32 + 8 * fq;
#pragma unroll
        for (int ai = 0; ai < 2; ++ai)
#pragma unroll
            for (int m = 0; m < 4; ++m) { const size_t r = (size_t)(row0 + ai * HALF + m * 16); const size_t off = r * ldc + col0; float ss = 0.f;
#pragma unroll
                for (int bj = 0; bj < 2; ++bj) { const f32x4 b0 = *(const f32x4*)(base + off + bj * HALF), b1 = *(const f32x4*)(base + off + bj * HALF + 4);
                    const f32x4 g0 = *(const f32x4*)(gain + col0 + bj * HALF), g1 = *(const f32x4*)(gain + col0 + bj * HALF + 4);
                    const f32x4 v0 = b0 + acc[ai][bj][m][0] * alpha, v1 = b1 + acc[ai][bj][m][1] * alpha;
                    *(f32x4*)(out + off + bj * HALF) = v0; *(f32x4*)(out + off + bj * HALF + 4) = v1;
                    ss += (v0[0] * v0[0] + v0[1] * v0[1]) + (v0[2] * v0[2] + v0[3] * v0[3]) + (v1[0] * v1[0] + v1[1] * v1[1]) + (v1[2] * v1[2] + v1[3] * v1[3]);
                    const f32x4 x0 = v0 * g0, x1 = v1 * g1;
                    u32x4 w; w.x = cvt_pk_bf16(x0[0], x0[1]); w.y = cvt_pk_bf16(x0[2], x0[3]); w.z = cvt_pk_bf16(x1[0], x1[1]); w.w = cvt_pk_bf16(x1[2], x1[3]);
                    *(u32x4*)(XB + off + bj * HALF) = w; }
                ss += __shfl_xor(ss, 16); ss += __shfl_xor(ss, 32);
                if (fq == 0) SSQ[r * 64 + u.pn * 4 + wc] = ss; }
    }
};
struct RstdOrder : StaticOrder {
    const float* ssq; PG8_LAS float* tab; float inv_n, eps;
    mutable int slot, pm0, pm1;
    __device__ __forceinline__ void init_r(const float* ssq_, PG8_LAS float* tab_, float inv_n_, float eps_) { ssq = ssq_; tab = tab_; inv_n = inv_n_; eps = eps_; slot = 0; pm0 = -1; pm1 = -1; }
    __device__ __forceinline__ void a_ready(const Unit& u) const {
        if ((slot ? pm1 : pm0) == u.pm) return;
        slot ^= 1; if (slot) pm1 = u.pm; else pm0 = u.pm;
        const int t = threadIdx.x, row = t >> 1, part = t & 1;
        const f32x4* p = (const f32x4*)(ssq + (size_t)(u.pm * BM + row) * 64 + part * 32);
        float s = 0.f;
#pragma unroll
        for (int j = 0; j < 8; ++j) { const f32x4 v = p[j]; s += (v[0] + v[1]) + (v[2] + v[3]); }
        s += __shfl_xor(s, 1);
        if (part == 0) tab[slot * 256 + row] = 1.0f / sqrtf(s * inv_n + eps);
        asm volatile("s_waitcnt lgkmcnt(0)" ::: "memory"); __builtin_amdgcn_s_barrier(); asm volatile("" ::: "memory");
    }
    __device__ __forceinline__ const PG8_LAS float* table(const Unit& u) const { return tab + ((pm0 == u.pm) ? 0 : 256); }
};
struct EpiSwiGLUR {
    static constexpr bool PERM = true, AFTER_DRAIN = false;
    bf16_t* O; int ldc; const RstdOrder* S;
    __device__ __forceinline__ void operator()(const f32x4 (&acc)[2][2][4][2], const Unit& u, int wr, int wc, int fr, int fq) const {
        const int row0 = u.pm * BM + wr * 64 + fr, col0 = u.pn * HALF + wc * 32 + 8 * fq; const PG8_LAS float* tb = S->table(u) + wr * 64 + fr;
#pragma unroll
        for (int ai = 0; ai < 2; ++ai)
#pragma unroll
            for (int m = 0; m < 4; ++m) { bf16_t* rowp = O + (size_t)(row0 + ai * HALF + m * 16) * ldc + col0; const float rs = tb[ai * HALF + m * 16];
                const f32x4 g0 = acc[ai][0][m][0] * rs, g1 = acc[ai][0][m][1] * rs, u0 = acc[ai][1][m][0] * rs, u1 = acc[ai][1][m][1] * rs;
                f32x4 v0, v1;
#pragma unroll
                for (int j = 0; j < 4; ++j) { v0[j] = silu_f(g0[j]) * u0[j]; v1[j] = silu_f(g1[j]) * u1[j]; }
                u32x4 w; w.x = cvt_pk_bf16(v0[0], v0[1]); w.y = cvt_pk_bf16(v0[2], v0[3]); w.z = cvt_pk_bf16(v1[0], v1[1]); w.w = cvt_pk_bf16(v1[2], v1[3]);
                *(u32x4*)rowp = w; }
    }
};
struct EpiBf16R {
    static constexpr bool PERM = true, AFTER_DRAIN = false;
    bf16_t* O; int ldc; const RstdOrder* S;
    __device__ __forceinline__ void operator()(const f32x4 (&acc)[2][2][4][2], const Unit& u, int wr, int wc, int fr, int fq) const {
        const int row0 = u.pm * BM + wr * 64 + fr, col0 = u.pn * BM + wc * 32 + 8 * fq; const PG8_LAS float* tb = S->table(u) + wr * 64 + fr;
#pragma unroll
        for (int ai = 0; ai < 2; ++ai)
#pragma unroll
            for (int m = 0; m < 4; ++m) { bf16_t* rowp = O + (size_t)(row0 + ai * HALF + m * 16) * ldc + col0; const float rs = tb[ai * HALF + m * 16];
#pragma unroll
                for (int bj = 0; bj < 2; ++bj) { const f32x4 v0 = acc[ai][bj][m][0] * rs, v1 = acc[ai][bj][m][1] * rs;
                    u32x4 w; w.x = cvt_pk_bf16(v0[0], v0[1]); w.y = cvt_pk_bf16(v0[2], v0[3]); w.z = cvt_pk_bf16(v1[0], v1[1]); w.w = cvt_pk_bf16(v1[2], v1[3]);
                    *(u32x4*)(rowp + bj * HALF) = w; } }
    }
};

template <class T, class = void> struct epi_has_mid { static constexpr bool value = false; };
template <class T> struct epi_has_mid<T, decltype((void)T::MID_T)> { static constexpr bool value = true; };
template <class Epi, class Sched, bool ALIGN_EPI = false, bool SP2 = false>
__device__ __forceinline__ void gemm_phase(PG8_LAS unsigned char* lds, const Gemm g, const Sched& S, const Epi& E) {
    const int tid = threadIdx.x, wid = __builtin_amdgcn_readfirstlane(tid >> 6), lane = tid & 63, wr = wid >> 2, wc = wid & 3, fr = lane & 15, fq = lane >> 4;
    const int K = g.K, nt = K / BK;
    unsigned voffA[2], voffB[2];
#pragma unroll
    for (int i = 0; i < 2; ++i) { int R, C; stage_rc(tid * 16 + i * 8192, R, C); const int Rb = Epi::PERM ? ((R & ~31) + perm32(R & 31)) : R;
        voffA[i] = (unsigned)(R * K + C) * 2u; voffB[i] = (unsigned)(Rb * K + C) * 2u; }
    const size_t kstep = (size_t)(BK * 2);
    const size_t hstep = (size_t)HALF * K * 2;
    const size_t tstep = 2 * hstep;
    const unsigned ldsbase = (unsigned)(size_t)lds;
    const unsigned ldsw = (unsigned)wid * 1024u;
    const int aoff = lds_byte(wr * 64 + fr, fq * 8), boff = lds_byte(wc * 32 + fr, fq * 8);
#define PG8_SA(b, h) (((b) * 2 + (h)) * HTB)
#define PG8_SB(b, h) ((4 + (b) * 2 + (h)) * HTB)
#define PG8_STAGE(bufoff, gbase, voff) do { _Pragma("unroll") for (int _i = 0; _i < 2; ++_i) \
        asm volatile("s_mov_b32 m0, %2\n\ts_nop 0\n\tglobal_load_lds_dwordx4 %0, %1" :: "v"((voff)[_i]), "s"((const char*)(gbase)), "s"(ldsbase + (unsigned)(bufoff) + ldsw + (unsigned)_i * 8192u) : "memory", "m0"); } while (0)
#define PG8_LDA(dst, b, h) do { _Pragma("unroll") for (int m = 0; m < 4; ++m) _Pragma("unroll") for (int k = 0; k < 2; ++k) dst[m][k] = *(const PG8_LAS bf16x8*)(lds + PG8_SA(b, h) + aoff + m * 2048 + k * 1024); } while (0)
#define PG8_LDB(dst, b, h) do { _Pragma("unroll") for (int n = 0; n < 2; ++n) _Pragma("unroll") for (int k = 0; k < 2; ++k) dst[n][k] = *(const PG8_LAS bf16x8*)(lds + PG8_SB(b, h) + boff + n * 2048 + k * 1024); } while (0)
#define PG8_MMA(ai, bj, At, Bt) do { __builtin_amdgcn_s_setprio(1); _Pragma("unroll") for (int m = 0; m < 4; ++m) _Pragma("unroll") for (int n = 0; n < 2; ++n) _Pragma("unroll") for (int k = 0; k < 2; ++k) \
        acc[ai][bj][m][n] = __builtin_amdgcn_mfma_f32_16x16x32_bf16(Bt[n][k], At[m][k], acc[ai][bj][m][n], 0, 0, 0); __builtin_amdgcn_s_setprio(0); } while (0)
#define PG8_WAIT_V(n) asm volatile("s_waitcnt vmcnt(" #n ")" ::: "memory")
#define PG8_WAIT_L(n) asm volatile("s_waitcnt lgkmcnt(" #n ")" ::: "memory")
#define PG8_BAR __builtin_amdgcn_s_barrier()
#define PG8_SCHED __builtin_amdgcn_sched_barrier(0)
    Unit cur, nxt; int ui = 0;
    if (!S.next(0, cur)) return;
    f32x4 acc[2][2][4][2];
#pragma unroll
    for (int a = 0; a < 2; ++a)
#pragma unroll
        for (int b = 0; b < 2; ++b)
#pragma unroll
            for (int m = 0; m < 4; ++m)
#pragma unroll
                for (int n = 0; n < 2; ++n) acc[a][b][m][n] = (f32x4){0.f, 0.f, 0.f, 0.f};
    bf16x8 At[4][2], B0[2][2], B1[2][2];
    const char* cA = (const char*)g.A + (size_t)cur.pm * tstep; const char* cB = (const char*)g.Bt + (size_t)cur.pn * tstep;
    S.a_ready(cur);
    if constexpr (SP2) {
        PG8_STAGE(PG8_SB(0, 0), cB, voffB); PG8_STAGE(PG8_SB(0, 1), cB + hstep, voffB); PG8_STAGE(PG8_SA(0, 0), cA, voffA); PG8_STAGE(PG8_SA(0, 1), cA + hstep, voffA);
        if (wr == 1) PG8_BAR;
        PG8_WAIT_V(2); PG8_BAR;
        PG8_STAGE(PG8_SB(1, 0), cB + kstep, voffB); PG8_STAGE(PG8_SA(1, 0), cA + kstep, voffA); PG8_STAGE(PG8_SB(1, 1), cB + hstep + kstep, voffB);
        PG8_WAIT_V(6); PG8_BAR;
    } else {
        PG8_STAGE(PG8_SB(0, 0), cB, voffB); PG8_STAGE(PG8_SA(0, 0), cA, voffA); PG8_STAGE(PG8_SB(0, 1), cB + hstep, voffB); PG8_STAGE(PG8_SA(0, 1), cA + hstep, voffA);
        if (wr == 1) PG8_BAR;
        PG8_WAIT_V(4); PG8_BAR;
        PG8_STAGE(PG8_SB(1, 0), cB + kstep, voffB); PG8_STAGE(PG8_SA(1, 0), cA + kstep, voffA); PG8_STAGE(PG8_SB(1, 1), cB + hstep + kstep, voffB);
        PG8_WAIT_V(6); PG8_BAR;
    }
    for (;;) {
        const bool has_next = S.next(ui + 1, nxt);
        const char* nA = has_next ? (const char*)g.A + (size_t)nxt.pm * tstep : cA; const char* nB = has_next ? (const char*)g.Bt + (size_t)nxt.pn * tstep : cB;
        for (int t = 0; t < nt; t += 2) {
            const bool last = (t == nt - 2);
            const char* a1 = cA + (size_t)(t + 1) * kstep;
            const char* a2 = last ? nA : cA + (size_t)(t + 2) * kstep; const char* b2 = last ? nB : cB + (size_t)(t + 2) * kstep;
            const char* a3 = a2 + kstep; const char* b3 = b2 + kstep;
            if (last && has_next) S.a_ready(nxt);
            if constexpr (epi_has_mid<Epi>::value) { if (t == Epi::MID_T) E.mid(acc, cur, wr, wc, fr, fq); }
            if constexpr (SP2) {
            PG8_LDB(B0, 0, 0); PG8_LDB(B1, 0, 1); PG8_SCHED; PG8_LDA(At, 0, 0); PG8_STAGE(PG8_SA(1, 1), a1 + hstep, voffA);
            PG8_WAIT_V(8); PG8_WAIT_L(0); PG8_BAR; PG8_MMA(0, 0, At, B0); PG8_MMA(0, 1, At, B1); PG8_BAR; PG8_SCHED;
            PG8_LDA(At, 0, 1); PG8_STAGE(PG8_SB(0, 0), b2, voffB); PG8_STAGE(PG8_SB(0, 1), b2 + hstep, voffB); PG8_STAGE(PG8_SA(0, 0), a2, voffA);
            PG8_WAIT_V(8); PG8_WAIT_L(0); PG8_BAR; PG8_MMA(1, 0, At, B0); PG8_MMA(1, 1, At, B1); PG8_BAR; PG8_SCHED;
            PG8_LDB(B0, 1, 0); PG8_LDB(B1, 1, 1); PG8_SCHED; PG8_LDA(At, 1, 0); PG8_STAGE(PG8_SA(0, 1), a2 + hstep, voffA);
            PG8_WAIT_V(8); PG8_WAIT_L(0); PG8_BAR; PG8_MMA(0, 0, At, B0); PG8_MMA(0, 1, At, B1); PG8_BAR; PG8_SCHED;
            PG8_LDA(At, 1, 1); PG8_STAGE(PG8_SB(1, 0), b3, voffB); PG8_STAGE(PG8_SB(1, 1), b3 + hstep, voffB); PG8_STAGE(PG8_SA(1, 0), a3, voffA);
            PG8_WAIT_V(8); PG8_WAIT_L(0); PG8_BAR; PG8_MMA(1, 0, At, B0); PG8_MMA(1, 1, At, B1); PG8_BAR; PG8_SCHED;
            } else {
            PG8_LDB(B0, 0, 0); PG8_SCHED; PG8_LDA(At, 0, 0); PG8_STAGE(PG8_SA(1, 1), a1 + hstep, voffA);
            PG8_WAIT_L(8); PG8_BAR; PG8_WAIT_L(0); PG8_MMA(0, 0, At, B0); PG8_BAR; PG8_SCHED;
            PG8_LDB(B1, 0, 1); PG8_STAGE(PG8_SB(0, 0), b2, voffB);
            PG8_BAR; PG8_WAIT_L(0); PG8_MMA(0, 1, At, B1); PG8_BAR;
            PG8_LDA(At, 0, 1); PG8_STAGE(PG8_SA(0, 0), a2, voffA);
            PG8_BAR; PG8_WAIT_L(0); PG8_MMA(1, 0, At, B0); PG8_BAR; PG8_SCHED;
            PG8_STAGE(PG8_SB(0, 1), b2 + hstep, voffB);
            PG8_WAIT_V(6); PG8_BAR; PG8_MMA(1, 1, At, B1); PG8_BAR;
            PG8_LDB(B0, 1, 0); PG8_SCHED; PG8_LDA(At, 1, 0); PG8_STAGE(PG8_SA(0, 1), a2 + hstep, voffA);
            PG8_WAIT_L(8); PG8_BAR; PG8_WAIT_L(0); PG8_MMA(0, 0, At, B0); PG8_BAR; PG8_SCHED;
            PG8_LDB(B1, 1, 1); PG8_STAGE(PG8_SB(1, 0), b3, voffB);
            PG8_BAR; PG8_WAIT_L(0); PG8_MMA(0, 1, At, B1); PG8_BAR;
            PG8_LDA(At, 1, 1); PG8_STAGE(PG8_SA(1, 0), a3, voffA);
            PG8_BAR; PG8_WAIT_L(0); PG8_MMA(1, 0, At, B0); PG8_BAR; PG8_SCHED;
            PG8_STAGE(PG8_SB(1, 1), b3 + hstep, voffB);
            PG8_WAIT_V(6); PG8_BAR; PG8_MMA(1, 1, At, B1); PG8_BAR;
            }
        }
        if constexpr (ALIGN_EPI) { if (wr == 0) PG8_BAR; }
        if constexpr (!Epi::AFTER_DRAIN) { E(acc, cur, wr, wc, fr, fq); S.done(cur); }
        if (!has_next) break;
#pragma unroll
        for (int a = 0; a < 2; ++a)
#pragma unroll
            for (int b = 0; b < 2; ++b)
#pragma unroll
                for (int m = 0; m < 4; ++m)
#pragma unroll
                    for (int n = 0; n < 2; ++n) acc[a][b][m][n] = (f32x4){0.f, 0.f, 0.f, 0.f};
        cur = nxt; cA = nA; cB = nB; ++ui;
        if constexpr (ALIGN_EPI) { if (wr == 1) PG8_BAR; }
    }
    PG8_WAIT_V(0);
    if constexpr (!ALIGN_EPI) { if (wr == 0) PG8_BAR; }
    PG8_BAR;
    if constexpr (Epi::AFTER_DRAIN) { E.fused(acc, cur, wr, wc, fr, fq, lds, wid, lane); S.done(cur); }
#undef PG8_SA
#undef PG8_SB
#undef PG8_STAGE
#undef PG8_LDA
#undef PG8_LDB
#undef PG8_MMA
#undef PG8_WAIT_V
#undef PG8_WAIT_L
#undef PG8_BAR
#undef PG8_SCHED
}
}

constexpr int NWAVES = 8;
constexpr int DM = 4096, BATCH = 4, SEQ = 2048, M = BATCH * SEQ, DFF = 11008;
constexpr int DCONV = 2048, GH = 4, DGK = 1024, DGV = 2048, HK = 256, HV = 512, GRANK = 16, CHUNK = 64, NCHUNK = SEQ / CHUNK;
constexpr int DIN_SRC = 20496;
constexpr int LDP = 20480;
constexpr int PC_CB = 0, PC_CC = 2048, PC_CU = 4096, PC_Q = 6144, PC_K = 7168, PC_V = 8192, PC_R = 10240, PC_GA = 12288, PC_GB = 16384;
constexpr float EPS = 1e-6f;

constexpr size_t MiB = 1u << 20;
constexpr size_t WS_CTL = 0, CTL_ZERO_BYTES = 1 * MiB;
constexpr size_t SZ_WGU = (size_t)2 * DFF * DM * 2, SZ_WD = (size_t)DM * DFF * 2, SZ_WIN = (size_t)LDP * DM * 2;
constexpr size_t WS_WGU1 = 1 * MiB;
constexpr size_t WS_WD1 = WS_WGU1 + SZ_WGU;
constexpr size_t WS_WIN = WS_WD1 + SZ_WD;
constexpr size_t WS_WCO = WS_WIN + SZ_WIN;
constexpr size_t WS_WGO = WS_WCO + (size_t)DM * DCONV * 2;
constexpr size_t WS_WMO = WS_WGO + (size_t)DM * DGV * 2;
constexpr size_t WS_WGU2 = WS_WMO + (size_t)DM * DM * 2;
constexpr size_t WS_WD2 = WS_WGU2 + SZ_WGU;
constexpr size_t WS_H = WS_WD2 + SZ_WD;
constexpr size_t WS_ACT = WS_H + (size_t)M * DM * 2;
constexpr size_t WS_SC = WS_ACT + (size_t)M * LDP * 2;
constexpr size_t WS_OG = WS_SC + (size_t)BATCH * NCHUNK * GH * 64 * 64 * 4;
constexpr size_t WS_OP = WS_OG + (size_t)M * DGV * 4;
constexpr size_t WS_CA = WS_OP + (size_t)M * DGV * 2;
constexpr size_t WS_MG = WS_CA + (size_t)M * DCONV * 2;
constexpr size_t WS_QA = WS_MG + (size_t)M * DM * 2;
constexpr size_t WS_KDT = WS_QA + (size_t)M * DGK * 2;
constexpr size_t WS_VT = WS_KDT + (size_t)M * DGK * 2;
constexpr size_t WS_GAM = WS_VT + (size_t)M * DGV * 2;
constexpr size_t WS_SSQ = WS_GAM + (size_t)BATCH * NCHUNK * GH * HK * 4;
constexpr size_t WS_AL = WS_SSQ + (size_t)M * 64 * 4;
constexpr size_t WS_WA = WS_AL + (size_t)M * 16 * 4;
constexpr size_t WS_END = WS_WA + (size_t)64 * DM * 2;
static_assert(WS_WGU1 % 256 == 0 && WS_WD1 % 256 == 0 && WS_WIN % 256 == 0 && WS_H % 256 == 0 && WS_ACT % 256 == 0 && WS_SC % 256 == 0 && WS_QA % 256 == 0, "alignment");
constexpr int CW_TMO = 0;
constexpr int CW_BAR = 4096;

constexpr int RING_OFF = 0, RING_BYTES = 131072;
constexpr int LDS_BYTES = 155648;
constexpr int MISC_OFF = LDS_BYTES - 256;
constexpr int RTAB_OFF = RING_BYTES;
static_assert(RING_BYTES + 2048 <= LDS_BYTES - 256, "LDS map");

constexpr int NPHASE = 12;
constexpr bool SCAN_SPLIT = true; constexpr int SCAN_UP_BLK = 88;
constexpr bool TAIL_CONV = true; constexpr int TAIL_W0 = 192;

#define GAS __attribute__((address_space(1)))
#define LAS __attribute__((address_space(3)))
typedef unsigned short bf16;
typedef unsigned v4u __attribute__((ext_vector_type(4)));
typedef unsigned v2u __attribute__((ext_vector_type(2)));
typedef float f32x4 __attribute__((ext_vector_type(4)));
typedef GAS unsigned gu32;
#define RLX_AGENT __ATOMIC_RELAXED, __HIP_MEMORY_SCOPE_AGENT
#define LDS_WAIT() asm volatile("s_waitcnt lgkmcnt(0)" ::: "memory")
#define VM_WAIT() asm volatile("s_waitcnt vmcnt(0)" ::: "memory")
__device__ __forceinline__ unsigned f2bf(float f) { unsigned u = __builtin_bit_cast(unsigned, f); return (u + 0x7fffu + ((u >> 16) & 1u)) >> 16; }
__device__ __forceinline__ unsigned pk2(float lo, float hi) { return f2bf(lo) | (f2bf(hi) << 16); }
typedef float f32x2_t __attribute__((ext_vector_type(2))); typedef __bf16 bf16x2_t __attribute__((ext_vector_type(2)));
__device__ __forceinline__ unsigned cvtpk(float lo, float hi) { f32x2_t v = {lo, hi}; bf16x2_t b = __builtin_convertvector(v, bf16x2_t); return __builtin_bit_cast(unsigned, b); }
__device__ __forceinline__ float bf2f(bf16 b) { return __uint_as_float(((unsigned)b) << 16); }
__device__ __forceinline__ float bflo(unsigned w) { return __uint_as_float(w << 16); }
__device__ __forceinline__ float bfhi(unsigned w) { return __uint_as_float(w & 0xffff0000u); }

#define XB_TMO      128
#define XB_XCNT(j)  (256  + 64 * (j))
#define XB_XSUB(j)  (1280 + 64 * (j))
#define XB_XGEN(j)  (2304 + 64 * (j))
#define XB_TOP      3328
#define XB_TOPGEN   3392
#define XCD_BAR_WORDS 3456
#define XB_SPIN_CAP (1u << 18)

__device__ __forceinline__ unsigned xb_ld(unsigned* p)              { return __hip_atomic_load(p, __ATOMIC_RELAXED, __HIP_MEMORY_SCOPE_AGENT); }
__device__ __forceinline__ unsigned xb_add(unsigned* p, unsigned v) { return __hip_atomic_fetch_add(p, v, __ATOMIC_RELAXED, __HIP_MEMORY_SCOPE_AGENT); }
__device__ __forceinline__ unsigned xb_xcc_id() { return (unsigned)__builtin_amdgcn_s_getreg((3 << 11) | 20) & 0xFu; }
#define XB_SPIN(cond, bar) do { unsigned _sp = 0; while (cond) { __builtin_amdgcn_s_sleep(1); \
    if ((++_sp & 255u) == 0u) { if (xb_ld(&(bar)[XB_TMO])) break; if (_sp > XB_SPIN_CAP) { atomicAdd(&(bar)[XB_TMO], 1u); break; } } } } while (0)

struct XcdBarrier {
    unsigned* bar; unsigned x;
    volatile LAS unsigned* st;
};

__device__ __forceinline__ XcdBarrier xcd_barrier_post(unsigned* bar, volatile LAS unsigned* st) {
    XcdBarrier b; b.bar = bar; b.x = xb_xcc_id(); b.st = st;
    if (threadIdx.x == 0) (void)xb_add(&bar[XB_XCNT(b.x)], 1u);
    return b;
}
__device__ __forceinline__ void xcd_barrier_complete(unsigned* bar, unsigned x, unsigned& nloc, unsigned& nx) {
    const unsigned G = gridDim.x * gridDim.y * gridDim.z;
    unsigned sum, cnt, mine, sp = 0u;
    for (;;) {
        sum = 0u; cnt = 0u; mine = 0u;
#pragma unroll
        for (unsigned j = 0; j < 16; ++j) { const unsigned c = xb_ld(&bar[XB_XCNT(j)]); sum += c; cnt += (c > 0u) ? 1u : 0u; mine = (j == x) ? c : mine; }
        if (sum == G) break;
        __builtin_amdgcn_s_sleep(1);
        if ((++sp & 255u) == 0u) { if (xb_ld(&bar[XB_TMO])) break; if (sp > XB_SPIN_CAP) { atomicAdd(&bar[XB_TMO], 1u); break; } }
    }
    nloc = mine > 0u ? mine : 1u; nx = cnt > 0u ? cnt : 1u;
}

__device__ __forceinline__ void xcd_barrier(const XcdBarrier& b) {
    asm volatile("s_waitcnt vmcnt(0)" ::: "memory");
    __syncthreads();
    if (threadIdx.x == 0) {
        unsigned* bar = b.bar;
        __builtin_amdgcn_s_waitcnt(0);
        unsigned nloc = b.st[0], nx = b.st[1];
        if (nloc == 0u) { xcd_barrier_complete(bar, b.x, nloc, nx); b.st[0] = nloc; b.st[1] = nx; }
        const unsigned old = xb_add(&bar[XB_XSUB(b.x)], 1u);
        const unsigned gen = old / nloc;
        if (old + 1u == (gen + 1u) * nloc) {
            __builtin_amdgcn_fence(__ATOMIC_RELEASE, "agent");
            asm volatile("s_waitcnt vmcnt(0)" ::: "memory");
            const unsigned og = xb_add(&bar[XB_TOP], 1u);
            const unsigned tg = og / nx;
            if (og + 1u == (tg + 1u) * nx) xb_add(&bar[XB_TOPGEN], 1u);
            else XB_SPIN(xb_ld(&bar[XB_TOPGEN]) == tg, bar);
            __builtin_amdgcn_fence(__ATOMIC_ACQUIRE, "agent");
            xb_add(&bar[XB_XGEN(b.x)], 1u);
            asm volatile("s_waitcnt vmcnt(0)" ::: "memory");
        } else {
            XB_SPIN(xb_ld(&bar[XB_XGEN(b.x)]) == gen, bar);
            __builtin_amdgcn_fence(__ATOMIC_ACQUIRE, "agent");
            asm volatile("s_waitcnt vmcnt(0)" ::: "memory");
        }
    }
    __syncthreads();
}

struct Frame {
    LAS unsigned char* lds;
    volatile LAS unsigned* MISC;
    gu32* ctl;
    int tid, lane, wave;
    int vcu, G;
};

__device__ __forceinline__ void unpack8(const v4u v, float (&o)[8]);
__device__ __forceinline__ float wave_sum(float v) {
#pragma unroll
    for (int o = 1; o < 64; o <<= 1) v += __shfl_xor(v, o);
    return v;
}

__device__ __forceinline__ void tr_item(const float* __restrict__ W, int ldw, bf16* __restrict__ WT, int K, int k0, int scol0, int nvalid, int drow0, LAS float* scr, int lane, const float* __restrict__ gk, int ldt, int koff) {
    const int c4 = (lane & 15) * 4, kr = lane >> 4;
    f32x4 v[16];
#pragma unroll
    for (int i = 0; i < 16; ++i) { v[i] = (f32x4){0.f, 0.f, 0.f, 0.f};
        if (c4 < nvalid) v[i] = __builtin_nontemporal_load((const f32x4*)(W + (size_t)(k0 + 4 * i + kr) * ldw + scol0 + c4)); }
    if (gk) {
#pragma unroll
        for (int i = 0; i < 16; ++i) v[i] = v[i] * gk[k0 + 4 * i + kr]; }
#pragma unroll
    for (int i = 0; i < 16; ++i) { LAS float* s = scr + (4 * i + kr) * 65 + c4; s[0] = v[i].x; s[1] = v[i].y; s[2] = v[i].z; s[3] = v[i].w; }
    LDS_WAIT();
    const int c = lane & 7, nn = lane >> 3;
#pragma unroll
    for (int jj = 0; jj < 8; ++jj) { const int n = 8 * jj + nn; const LAS float* s = scr + (8 * c) * 65 + n;
        v4u o; o.x = cvtpk(s[0], s[65]); o.y = cvtpk(s[130], s[195]); o.z = cvtpk(s[260], s[325]); o.w = cvtpk(s[390], s[455]);
        *(v4u*)(WT + (size_t)(drow0 + n) * ldt + koff + k0 + 8 * c) = o; }
    LDS_WAIT();
}
__device__ __forceinline__ void conv_seg(Frame& F, const float* W, int ldw, int K, int scol0, int nblk, int nvalid_first, int nvalid_rest, bf16* WT, int sh, int strideA, int off, LAS float* scr, const float* gk = nullptr, int gw_ = -1, int ngw_ = 0, int ldt = 0, int koff = 0) {
    const int gw = gw_ >= 0 ? gw_ : F.vcu * NWAVES + F.wave, NGW = gw_ >= 0 ? ngw_ : F.G * NWAVES;
    const int nitems = (K / 64) * nblk;
    for (int it = gw; it < nitems; it += NGW) { const int kb = it / nblk, nb = it - kb * nblk;
        const int drow = (nb >> sh) * strideA + (nb & ((1 << sh) - 1)) * 64 + off;
        tr_item(W, ldw, WT, K, kb * 64, scol0 + nb * 64, nb == 0 ? nvalid_first : nvalid_rest, drow, scr, F.lane, gk, ldt ? ldt : K, koff); }
}
#define GLD16NT(dst, ptr) asm volatile("global_load_dwordx4 %0, %1, off nt" : "=v"(dst) : "v"(ptr) : "memory")
#define TR_WAIT(v) asm volatile("s_waitcnt vmcnt(16)" : "+v"(v[0]), "+v"(v[1]), "+v"(v[2]), "+v"(v[3]), "+v"(v[4]), "+v"(v[5]), "+v"(v[6]), "+v"(v[7]), \
    "+v"(v[8]), "+v"(v[9]), "+v"(v[10]), "+v"(v[11]), "+v"(v[12]), "+v"(v[13]), "+v"(v[14]), "+v"(v[15]) :: "memory")
#define TR_DRAIN(v) asm volatile("s_waitcnt vmcnt(0)" : "+v"(v[0]), "+v"(v[1]), "+v"(v[2]), "+v"(v[3]), "+v"(v[4]), "+v"(v[5]), "+v"(v[6]), "+v"(v[7]), \
    "+v"(v[8]), "+v"(v[9]), "+v"(v[10]), "+v"(v[11]), "+v"(v[12]), "+v"(v[13]), "+v"(v[14]), "+v"(v[15]) :: "memory")
__device__ __forceinline__ void tr_issue(v4u (&v)[16], const float* W, int ldw, int k0, int scol0, int lane) {
    const float* p = W + (size_t)(k0 + (lane >> 4)) * ldw + scol0 + (lane & 15) * 4;
#pragma unroll
    for (int i = 0; i < 16; ++i) { const float* pi = p + (size_t)(4 * i) * ldw; GLD16NT(v[i], pi); }
}
__device__ __forceinline__ void tr_process(const v4u (&v)[16], bf16* __restrict__ WT, int K, int k0, int nvalid, int drow0, LAS float* scr, int lane, const float* __restrict__ gk, int ldt, int koff) {
    const int c4 = (lane & 15) * 4, kr = lane >> 4; const bool ok = c4 < nvalid;
#pragma unroll
    for (int i = 0; i < 16; ++i) { const float g = gk ? gk[k0 + 4 * i + kr] : 1.0f; LAS float* s = scr + (4 * i + kr) * 65 + c4;
        s[0] = ok ? __uint_as_float(v[i].x) * g : 0.f; s[1] = ok ? __uint_as_float(v[i].y) * g : 0.f; s[2] = ok ? __uint_as_float(v[i].z) * g : 0.f; s[3] = ok ? __uint_as_float(v[i].w) * g : 0.f; }
    LDS_WAIT();
    const int c = lane & 7, nn = lane >> 3;
#pragma unroll
    for (int jj = 0; jj < 8; ++jj) { const int n = 8 * jj + nn; const LAS float* s = scr + (8 * c) * 65 + n;
        v4u o; o.x = cvtpk(s[0], s[65]); o.y = cvtpk(s[130], s[195]); o.z = cvtpk(s[260], s[325]); o.w = cvtpk(s[390], s[455]);
        *(v4u*)(WT + (size_t)(drow0 + n) * ldt + koff + k0 + 8 * c) = o; }
    LDS_WAIT();
}
__device__ __forceinline__ void conv_seg_pipe(Frame& F, const float* W, int ldw, int K, int scol0, int nblk, int nvalid_first, int nvalid_rest, bf16* WT, int sh, int strideA, int off, LAS float* scr, const float* gk, int gw, int NGW, int ldt_ = 0, int koff = 0) {
    const int ldt = ldt_ ? ldt_ : K;
    const int nitems = (K / 64) * nblk;
    int it = gw; if (it >= nitems) return;
    v4u A[16], B[16];
    VM_WAIT();
    { const int kb = it / nblk, nb = it - kb * nblk; tr_issue(A, W, ldw, kb * 64, scol0 + nb * 64, F.lane); }
    for (;;) {
        { const int nx = it + NGW, has = nx < nitems, ix = has ? nx : it; const int kb = ix / nblk, nb = ix - kb * nblk; tr_issue(B, W, ldw, kb * 64, scol0 + nb * 64, F.lane);
          TR_WAIT(A);
          const int kc = it / nblk, nc = it - kc * nblk;
          tr_process(A, WT, K, kc * 64, nc == 0 ? nvalid_first : nvalid_rest, (nc >> sh) * strideA + (nc & ((1 << sh) - 1)) * 64 + off, scr, F.lane, gk, ldt, koff);
          if (!has) break; it = nx; }
        { const int nx = it + NGW, has = nx < nitems, ix = has ? nx : it; const int kb = ix / nblk, nb = ix - kb * nblk; tr_issue(A, W, ldw, kb * 64, scol0 + nb * 64, F.lane);
          TR_WAIT(B);
          const int kc = it / nblk, nc = it - kc * nblk;
          tr_process(B, WT, K, kc * 64, nc == 0 ? nvalid_first : nvalid_rest, (nc >> sh) * strideA + (nc & ((1 << sh) - 1)) * 64 + off, scr, F.lane, gk, ldt, koff);
          if (!has) break; it = nx; }
    }
    TR_DRAIN(A); TR_DRAIN(B);
}
__device__ __forceinline__ void rms_rows_bf16(Frame& F, const float* src, const float* g, bf16* dst) {
    const int gw = F.vcu * NWAVES + F.wave, NGW = F.G * NWAVES;
    for (int m = gw; m < M; m += NGW) {
        const f32x4* xr = (const f32x4*)(src + (size_t)m * DM) + F.lane;
        f32x4 v[16]; float s = 0.f;
#pragma unroll
        for (int j = 0; j < 16; ++j) { v[j] = xr[64 * j]; s += (v[j].x * v[j].x + v[j].y * v[j].y) + (v[j].z * v[j].z + v[j].w * v[j].w); }
        const float rstd = 1.0f / sqrtf(wave_sum(s) * (1.0f / DM) + EPS);
        const f32x4* gr = (const f32x4*)g + F.lane;
        v2u* o8 = (v2u*)(dst + (size_t)m * DM) + F.lane;
#pragma unroll
        for (int j = 0; j < 16; ++j) { const f32x4 gg = gr[64 * j]; v2u w; w.x = pk2(v[j].x * rstd * gg.x, v[j].y * rstd * gg.y); w.y = pk2(v[j].z * rstd * gg.z, v[j].w * rstd * gg.w); o8[64 * j] = w; }
    }
}
__device__ __forceinline__ void rms_rows_final(Frame& F, const bf16* src, float* dst, const float* g) {
    const int gw = F.vcu * NWAVES + F.wave, NGW = F.G * NWAVES;
    for (int m = gw; m < M; m += NGW) {
        const v4u* xr = (const v4u*)(src + (size_t)m * DM) + F.lane;
        v4u v[8]; float s = 0.f;
#pragma unroll
        for (int j = 0; j < 8; ++j) { v[j] = xr[64 * j]; float x[8]; unpack8(v[j], x);
#pragma unroll
            for (int e = 0; e < 8; ++e) s += x[e] * x[e]; }
        const float rstd = 1.0f / sqrtf(wave_sum(s) * (1.0f / DM) + EPS);
#pragma unroll
        for (int j = 0; j < 8; ++j) { float x[8]; unpack8(v[j], x); const int c = 8 * (F.lane + 64 * j);
            const f32x4 g0 = *(const f32x4*)(g + c), g1 = *(const f32x4*)(g + c + 4);
            f32x4* o = (f32x4*)(dst + (size_t)m * DM + c);
            o[0] = (f32x4){x[0] * rstd * g0.x, x[1] * rstd * g0.y, x[2] * rstd * g0.z, x[3] * rstd * g0.w};
            o[1] = (f32x4){x[4] * rstd * g1.x, x[5] * rstd * g1.y, x[6] * rstd * g1.z, x[7] * rstd * g1.w}; }
    }
}


__device__ __forceinline__ void unpack8(const v4u v, float (&o)[8]) { o[0] = bflo(v.x); o[1] = bfhi(v.x); o[2] = bflo(v.y); o[3] = bfhi(v.y); o[4] = bflo(v.z); o[5] = bfhi(v.z); o[6] = bflo(v.w); o[7] = bfhi(v.w); }
__device__ __forceinline__ void conv_branch(Frame& F, const bf16* PROJ, const float* conv_w, const float* conv_b, bf16* CA) {
    const int gt = blockIdx.x * 512 + F.tid, NT = F.G * 512;
    for (int p = gt; p < (M / 16) * (DCONV / 8); p += NT) { const int c = (p % (DCONV / 8)) * 8, t0 = (p / (DCONV / 8)) * 16; const int s0 = t0 % SEQ;
        float w0[8], w1[8], w2[8], bb[8], um2[8], um1[8];
#pragma unroll
        for (int e = 0; e < 8; e += 4) { const f32x4 a = *(const f32x4*)(conv_w + c + e), b1 = *(const f32x4*)(conv_w + DCONV + c + e), c2 = *(const f32x4*)(conv_w + 2 * DCONV + c + e), d = *(const f32x4*)(conv_b + c + e);
#pragma unroll
            for (int q = 0; q < 4; ++q) { w0[e + q] = a[q]; w1[e + q] = b1[q]; w2[e + q] = c2[q]; bb[e + q] = d[q]; } }
        const bf16* row = PROJ + (size_t)t0 * LDP + c;
        if (s0 > 0) { float a[8], b2[8]; unpack8(*(const v4u*)(row - 2 * (size_t)LDP + PC_CC), a); unpack8(*(const v4u*)(row - 2 * (size_t)LDP + PC_CU), b2);
#pragma unroll
            for (int e = 0; e < 8; ++e) um2[e] = a[e] * b2[e];
            unpack8(*(const v4u*)(row - (size_t)LDP + PC_CC), a); unpack8(*(const v4u*)(row - (size_t)LDP + PC_CU), b2);
#pragma unroll
            for (int e = 0; e < 8; ++e) um1[e] = a[e] * b2[e]; }
        else {
#pragma unroll
            for (int e = 0; e < 8; ++e) { um2[e] = 0.f; um1[e] = 0.f; } }
#pragma unroll 4
        for (int tt = 0; tt < 16; ++tt) { float cc[8], cu[8], cb[8], o[8];
            unpack8(*(const v4u*)(row + (size_t)tt * LDP + PC_CC), cc); unpack8(*(const v4u*)(row + (size_t)tt * LDP + PC_CU), cu); unpack8(*(const v4u*)(row + (size_t)tt * LDP + PC_CB), cb);
#pragma unroll
            for (int e = 0; e < 8; ++e) { const float u = cc[e] * cu[e]; o[e] = cb[e] * (bb[e] + w0[e] * um2[e] + w1[e] * um1[e] + w2[e] * u); um2[e] = um1[e]; um1[e] = u; }
            *(v4u*)(CA + (size_t)(t0 + tt) * (DCONV + DGV) + c) = (v4u){cvtpk(o[0], o[1]), cvtpk(o[2], o[3]), cvtpk(o[4], o[5]), cvtpk(o[6], o[7])}; }
    }
}

typedef short s16x8 __attribute__((ext_vector_type(8)));
typedef float f32x16 __attribute__((ext_vector_type(16)));
__device__ __forceinline__ int crow32(int reg, int hh) { return (reg & 3) + 8 * (reg >> 2) + 4 * hh; }

__device__ __forceinline__ void vt_transpose(Frame& F, const bf16* PROJ, bf16* VT) {
    LAS bf16* scr = (LAS bf16*)(F.lds + F.wave * 8448);
    const int gw = F.vcu * NWAVES + F.wave, NGW = F.G * NWAVES, lane = F.lane;
    for (int it = gw; it < (M / CHUNK) * (DGV / 64); it += NGW) { const int c = it >> 5, vb = it & 31;
#pragma unroll
        for (int k = 0; k < 8; ++k) { const int p = lane + 64 * k, tok = p >> 3, c8 = (p & 7) * 8;
            const v4u v = *(const v4u*)(PROJ + (size_t)(c * CHUNK + tok) * LDP + PC_V + vb * 64 + c8);
            LAS unsigned* d = (LAS unsigned*)(scr + tok * 66 + c8); d[0] = v.x; d[1] = v.y; d[2] = v.z; d[3] = v.w; }
        LDS_WAIT();
        const int cc = lane & 7, nn = lane >> 3;
#pragma unroll
        for (int jj = 0; jj < 8; ++jj) { const int dv = 8 * jj + nn; const LAS bf16* sp = scr + (8 * cc) * 66 + dv;
            v4u o; o.x = (unsigned)sp[0] | ((unsigned)sp[66] << 16); o.y = (unsigned)sp[132] | ((unsigned)sp[198] << 16); o.z = (unsigned)sp[264] | ((unsigned)sp[330] << 16); o.w = (unsigned)sp[396] | ((unsigned)sp[462] << 16);
            const int dvg = vb * 64 + dv;
            *(v4u*)(VT + ((((((size_t)c * GH + (dvg >> 9)) * 16 + ((dvg >> 5) & 15)) * 4 + (cc >> 1)) * 64 + 32 * (cc & 1) + (dvg & 31)) * 8)) = o; }
        LDS_WAIT();
    }
}
__device__ __forceinline__ size_t qaf_index(int item, int i, int d) { const int w = d >> 5, s = (d >> 4) & 1, dd = d & 15, hh = (dd >> 2) & 1, j = (dd & 3) + 4 * (dd >> 3);
    return ((((size_t)item * 8 + w) * 4 + (i >> 5) * 2 + s) * 64 + 32 * hh + (i & 31)) * 8 + j; }
__device__ __forceinline__ void gla_prep(Frame& F, const bf16* PROJ, const float* AL32, const float* w_up, const float* b_alpha, bf16* SC, bf16* QA, bf16* KDT, float* GAM) {
    LAS float* Lc = (LAS float*)(F.lds);
    LAS bf16* QX = (LAS bf16*)(F.lds + 65792);
    LAS bf16* KX = (LAS bf16*)(F.lds + 65792 + 33792);
    LAS float* tot = (LAS float*)(F.lds + 65792 + 2 * 33792);
    LAS float* AL = (LAS float*)(F.lds + 65792 + 2 * 33792 + 2048);
    const int tid = F.tid, lane = F.lane, r16 = lane & 15, q4 = lane >> 4;
    for (int item = blockIdx.x; item < BATCH * NCHUNK * GH; item += F.G) {
        const int h = item % GH, n = (item / GH) % NCHUNK, b = item / (GH * NCHUNK);
        const int r0 = b * SEQ + n * CHUNK;
        if (tid < 256) *(LAS f32x4*)(AL + tid * 4) = *(const f32x4*)(AL32 + (size_t)r0 * 16 + tid * 4);
        const int d = tid & 255, half = tid >> 8;
        for (int p = tid; p < 64 * 32; p += 512) { const int i = p >> 5, c8 = (p & 31) * 8;
            *(LAS v4u*)(QX + i * 264 + c8) = *(const v4u*)(PROJ + (size_t)(r0 + i) * LDP + PC_Q + h * HK + c8);
            *(LAS v4u*)(KX + i * 264 + c8) = *(const v4u*)(PROJ + (size_t)(r0 + i) * LDP + PC_K + h * HK + c8); }
        __syncthreads();
        unsigned qraw[32], kraw[32];
#pragma unroll
        for (int ii = 0; ii < 32; ++ii) { qraw[ii] = QX[(half * 32 + ii) * 264 + d]; kraw[ii] = KX[(half * 32 + ii) * 264 + d]; }
        __syncthreads();
        {
            float wu[GRANK];
#pragma unroll
            for (int r = 0; r < GRANK; ++r) wu[r] = w_up[r * DGK + h * HK + d];
            const float ba = b_alpha[h * HK + d];
            float run = 0.f;
#pragma unroll 4
            for (int ii = 0; ii < 32; ++ii) { const int i = half * 32 + ii;
                const LAS f32x4* ap = (const LAS f32x4*)(AL + i * 16); const f32x4 a0 = ap[0], a1 = ap[1], a2 = ap[2], a3 = ap[3];
                float z = ba;
                z += a0.x * wu[0] + a0.y * wu[1] + a0.z * wu[2] + a0.w * wu[3] + a1.x * wu[4] + a1.y * wu[5] + a1.z * wu[6] + a1.w * wu[7];
                z += a2.x * wu[8] + a2.y * wu[9] + a2.z * wu[10] + a2.w * wu[11] + a3.x * wu[12] + a3.y * wu[13] + a3.z * wu[14] + a3.w * wu[15];
                run += (fminf(z, 0.f) - __logf(1.0f + __expf(-fabsf(z)))) * (1.0f / 16.0f);
                Lc[i * 257 + d] = run; }
            tot[half * 256 + d] = run;
        }
        __syncthreads();
        const float t0 = tot[d], t1 = tot[256 + d], llast = t0 + t1, off = half ? t0 : 0.f;
#pragma unroll
        for (int g = 0; g < 4; ++g) {
            unsigned kdp[4];
#pragma unroll
            for (int e2 = 0; e2 < 4; ++e2) { float kd2[2];
#pragma unroll
                for (int e = 0; e < 2; ++e) { const int ii = g * 8 + e2 * 2 + e, i = half * 32 + ii;
                    const float Lv = Lc[i * 257 + d] + off; const float qv = __uint_as_float(qraw[ii] << 16), kv = __uint_as_float(kraw[ii] << 16);
                    const float ea = __expf(Lv), eb = __expf(-Lv);
                    QX[i * 264 + d] = (bf16)f2bf(qv * 0.0625f * ea);
                    KX[i * 264 + d] = (bf16)f2bf(kv * eb);
                    kd2[e] = kv * __expf(llast - Lv); }
                kdp[e2] = cvtpk(kd2[0], kd2[1]); }
            *(v4u*)(KDT + ((((size_t)item * 8 + (d >> 5)) * 4 + 2 * half + (g >> 1)) * 64 + 32 * (g & 1) + (d & 31)) * 8) = (v4u){kdp[0], kdp[1], kdp[2], kdp[3]};
        }
        if (half == 0) GAM[(size_t)item * HK + d] = __expf(llast);
        __syncthreads();
        {
            const int w = F.wave, r = lane & 31, hh = lane >> 5;
#pragma unroll
            for (int mt = 0; mt < 2; ++mt)
#pragma unroll
                for (int ks = 0; ks < 2; ++ks) { const LAS bf16* src = QX + (32 * mt + r) * 264 + 32 * w + 16 * ks + 4 * hh;
                    const v2u lo8 = *(const LAS v2u*)src, hi8 = *(const LAS v2u*)(src + 8);
                    *(v4u*)(QA + ((((size_t)item * 8 + w) * 4 + mt * 2 + ks) * 64 + lane) * 8) = (v4u){lo8.x, lo8.y, hi8.x, hi8.y}; }
        }
        f32x4 lo[2];
#pragma unroll
        for (int e = 0; e < 2; ++e) { const int blk = 2 * F.wave + e, bi = blk >> 2, bj = blk & 3; f32x4 a = (f32x4){0.f, 0.f, 0.f, 0.f};
#pragma unroll
            for (int kk = 0; kk < 8; ++kk) { const s16x8 av = *(const LAS s16x8*)(QX + (16 * bi + r16) * 264 + 32 * kk + 8 * q4), bv = *(const LAS s16x8*)(KX + (16 * bj + r16) * 264 + 32 * kk + 8 * q4);
                a = __builtin_amdgcn_mfma_f32_16x16x32_bf16(av, bv, a, 0, 0, 0); }
            lo[e] = a; }
        __syncthreads();
#pragma unroll
        for (int ii = 0; ii < 32; ++ii) { const int i = half * 32 + ii; const float Lv = Lc[i * 257 + d] + off; const float qv = __uint_as_float(qraw[ii] << 16), kv = __uint_as_float(kraw[ii] << 16);
            const float ea = __expf(Lv), eb = __expf(-Lv);
            QX[i * 264 + d] = (bf16)f2bf(qv * 0.0625f * eb); KX[i * 264 + d] = (bf16)f2bf(kv * ea); }
        __syncthreads();
#pragma unroll
        for (int e = 0; e < 2; ++e) { const int blk = 2 * F.wave + e, bi = blk >> 2, bj = blk & 3; f32x4 a = (f32x4){0.f, 0.f, 0.f, 0.f};
#pragma unroll
            for (int kk = 0; kk < 8; ++kk) { const s16x8 av = *(const LAS s16x8*)(QX + (16 * bi + r16) * 264 + 32 * kk + 8 * q4), bv = *(const LAS s16x8*)(KX + (16 * bj + r16) * 264 + 32 * kk + 8 * q4);
                a = __builtin_amdgcn_mfma_f32_16x16x32_bf16(av, bv, a, 0, 0, 0); }
            const int j = 16 * bj + r16;
#pragma unroll
            for (int reg = 0; reg < 4; ++reg) { const int i = 16 * bi + 4 * q4 + reg; SC[((((size_t)item * 4 + (j >> 4)) * 2 + (i >> 5)) * 64 + 32 * ((j >> 3) & 1) + (i & 31)) * 8 + (j & 7)] = (bf16)f2bf((i >= j) ? lo[e][reg] : a[reg]); } }
        __syncthreads();
    }
}
#define GLD16(dst, ptr, off) asm volatile("global_load_dwordx4 %0, %1, off offset:" #off : "=v"(dst) : "v"(ptr) : "memory")
struct ScanMain { v4u qa[2][2], p[2], vtp; };
struct ScanLate { v4u kd[4], vt[4], gm[4]; };
__device__ __forceinline__ void scan_issue_main(ScanMain& o, const bf16* QA, const bf16* VT, const bf16* SC, int b, int h, int sl, int n, int w, int lane) {
    const size_t item = ((size_t)b * NCHUNK + n) * GH + h; const size_t chunk = (size_t)b * NCHUNK + n;
    const bf16* q0 = QA + ((item * 8 + w) * 4) * 512 + lane * 8;
    const bf16* vp2 = VT + ((((chunk * GH + h) * 16 + sl) * 4 + (w & 3)) * 64 + lane) * 8;
    const bf16* p0 = SC + ((item * 4 + (w & 3)) * 2) * 512 + lane * 8;
    GLD16(o.qa[0][0], q0, 0); GLD16(o.qa[0][1], q0, 1024); GLD16(o.qa[1][0], q0, 2048); GLD16(o.qa[1][1], q0, 3072);
    GLD16(o.p[0], p0, 0); GLD16(o.p[1], p0, 1024); GLD16(o.vtp, vp2, 0);
}
__device__ __forceinline__ void scan_issue_late(ScanLate& o, const bf16* KDT, const bf16* VT, const float* GAM, int b, int h, int sl, int n, int w, int lane) {
    const size_t item = ((size_t)b * NCHUNK + n) * GH + h; const size_t chunk = (size_t)b * NCHUNK + n;
    const bf16* kp = KDT + ((item * 8 + w) * 4) * 512 + lane * 8;
    const bf16* vp = VT + ((((chunk * GH + h) * 16 + sl) * 4) * 64 + lane) * 8;
    const float* gp = GAM + item * HK + 32 * w + 4 * (lane >> 5);
    GLD16(o.kd[0], kp, 0); GLD16(o.kd[1], kp, 1024); GLD16(o.kd[2], kp, 2048); GLD16(o.kd[3], kp, 3072);
    GLD16(o.vt[0], vp, 0); GLD16(o.vt[1], vp, 1024); GLD16(o.vt[2], vp, 2048); GLD16(o.vt[3], vp, 3072);
    GLD16(o.gm[0], gp, 0); GLD16(o.gm[1], gp, 32); GLD16(o.gm[2], gp, 64); GLD16(o.gm[3], gp, 96);
}
#define SCAN_WAIT_MAIN(o) asm volatile("s_waitcnt vmcnt(19)" : "+v"(o.qa[0][0]), "+v"(o.qa[0][1]), "+v"(o.qa[1][0]), "+v"(o.qa[1][1]), "+v"(o.p[0]), "+v"(o.p[1]), "+v"(o.vtp) :: "memory")
#define SCAN_WAIT_LATE(o) asm volatile("s_waitcnt vmcnt(7)" : "+v"(o.kd[0]), "+v"(o.kd[1]), "+v"(o.kd[2]), "+v"(o.kd[3]), "+v"(o.vt[0]), "+v"(o.vt[1]), "+v"(o.vt[2]), "+v"(o.vt[3]), \
    "+v"(o.gm[0]), "+v"(o.gm[1]), "+v"(o.gm[2]), "+v"(o.gm[3]) :: "memory")
#define SCAN_DRAIN_MAIN(o) asm volatile("s_waitcnt vmcnt(0)" : "+v"(o.qa[0][0]), "+v"(o.qa[0][1]), "+v"(o.qa[1][0]), "+v"(o.qa[1][1]), "+v"(o.p[0]), "+v"(o.p[1]), "+v"(o.vtp) :: "memory")
#define SCAN_DRAIN_LATE(o) asm volatile("s_waitcnt vmcnt(0)" : "+v"(o.kd[0]), "+v"(o.kd[1]), "+v"(o.kd[2]), "+v"(o.kd[3]), "+v"(o.vt[0]), "+v"(o.vt[1]), "+v"(o.vt[2]), "+v"(o.vt[3]), \
    "+v"(o.gm[0]), "+v"(o.gm[1]), "+v"(o.gm[2]), "+v"(o.gm[3]) :: "memory")
__device__ __forceinline__ void scan_out(const ScanMain& c, const f32x16& S, LAS float* buf, int w, int r, int hh) {
    f32x16 op[2];
#pragma unroll
    for (int mt = 0; mt < 2; ++mt)
#pragma unroll
        for (int i = 0; i < 16; ++i) op[mt][i] = 0.f;
    if (w < 4) {
#pragma unroll
        for (int mt = 0; mt < 2; ++mt) op[mt] = __builtin_amdgcn_mfma_f32_32x32x16_bf16(__builtin_bit_cast(s16x8, c.p[mt]), __builtin_bit_cast(s16x8, c.vtp), op[mt], 0, 0, 0); }
    const s16x8 sb0 = __builtin_bit_cast(s16x8, (v4u){cvtpk(S[0], S[1]), cvtpk(S[2], S[3]), cvtpk(S[4], S[5]), cvtpk(S[6], S[7])});
    const s16x8 sb1 = __builtin_bit_cast(s16x8, (v4u){cvtpk(S[8], S[9]), cvtpk(S[10], S[11]), cvtpk(S[12], S[13]), cvtpk(S[14], S[15])});
#pragma unroll
    for (int mt = 0; mt < 2; ++mt) { op[mt] = __builtin_amdgcn_mfma_f32_32x32x16_bf16(__builtin_bit_cast(s16x8, c.qa[mt][0]), sb0, op[mt], 0, 0, 0);
        op[mt] = __builtin_amdgcn_mfma_f32_32x32x16_bf16(__builtin_bit_cast(s16x8, c.qa[mt][1]), sb1, op[mt], 0, 0, 0); }
#pragma unroll
    for (int mt = 0; mt < 2; ++mt)
#pragma unroll
        for (int i = 0; i < 16; ++i) buf[w * 2048 + (32 * mt + crow32(i, hh)) * 32 + r] = op[mt][i];
}
__device__ __forceinline__ void scan_state(const ScanLate& c, f32x16& S) {
#pragma unroll
    for (int i = 0; i < 16; ++i) S[i] *= __uint_as_float(c.gm[i >> 2][i & 3]);
#pragma unroll
    for (int kk = 0; kk < 4; ++kk) S = __builtin_amdgcn_mfma_f32_32x32x16_bf16(__builtin_bit_cast(s16x8, c.kd[kk]), __builtin_bit_cast(s16x8, c.vt[kk]), S, 0, 0, 0);
}
__device__ __forceinline__ void scan_reduce(const LAS float* buf, float* OG, int r0, int h, int sl, int tid) {
    const int tok = tid >> 3, v4 = (tid & 7) * 4; const LAS float* p = buf + tok * 32 + v4;
    f32x4 a = *(const LAS f32x4*)p + *(const LAS f32x4*)(p + 2048);
    a += *(const LAS f32x4*)(p + 2 * 2048) + *(const LAS f32x4*)(p + 3 * 2048);
    a += *(const LAS f32x4*)(p + 4 * 2048) + *(const LAS f32x4*)(p + 5 * 2048);
    a += *(const LAS f32x4*)(p + 6 * 2048) + *(const LAS f32x4*)(p + 7 * 2048);
    *(f32x4*)(OG + (size_t)(r0 + tok) * DGV + h * HV + sl * 32 + v4) = a;
}
__device__ __forceinline__ void gla_scan(Frame& F, const bf16* QA, const bf16* KDT, const bf16* VT, const bf16* SC, const float* GAM, float* OG) {
    LAS float* RB = (LAS float*)(F.lds);
    const int tid = F.tid, lane = F.lane, w = F.wave, r = lane & 31, hh = lane >> 5;
    for (int unit = blockIdx.x; unit < BATCH * GH * 16; unit += F.G) {
        const int sl = unit & 15, h = (unit >> 4) % GH, b = unit / (16 * GH);
        f32x16 S;
#pragma unroll
        for (int i = 0; i < 16; ++i) S[i] = 0.f;
        ScanMain A, B; ScanLate L;
        VM_WAIT();
        scan_issue_main(A, QA, VT, SC, b, h, sl, 0, w, lane);
        scan_issue_late(L, KDT, VT, GAM, b, h, sl, 0, w, lane);
#pragma unroll 1
        for (int n = 0; n < NCHUNK; n += 2) {
            scan_issue_main(B, QA, VT, SC, b, h, sl, n + 1, w, lane);
            SCAN_WAIT_MAIN(A);
            scan_out(A, S, RB, w, r, hh);
            SCAN_WAIT_LATE(L);
            scan_state(L, S);
            scan_issue_late(L, KDT, VT, GAM, b, h, sl, n + 1, w, lane);
            asm volatile("s_waitcnt lgkmcnt(0)" ::: "memory"); __builtin_amdgcn_s_barrier(); asm volatile("" ::: "memory");
            scan_reduce(RB, OG, b * SEQ + n * CHUNK, h, sl, tid);
            scan_issue_main(A, QA, VT, SC, b, h, sl, (n + 2 < NCHUNK) ? n + 2 : n, w, lane);
            SCAN_WAIT_MAIN(B);
            scan_out(B, S, RB + 16384, w, r, hh);
            SCAN_WAIT_LATE(L);
            scan_state(L, S);
            scan_issue_late(L, KDT, VT, GAM, b, h, sl, (n + 2 < NCHUNK) ? n + 2 : n, w, lane);
            asm volatile("s_waitcnt lgkmcnt(0)" ::: "memory"); __builtin_amdgcn_s_barrier(); asm volatile("" ::: "memory");
            scan_reduce(RB + 16384, OG, b * SEQ + (n + 1) * CHUNK, h, sl, tid);
        }
        SCAN_DRAIN_MAIN(A); SCAN_DRAIN_MAIN(B); SCAN_DRAIN_LATE(L);
        __syncthreads();
    }
}
struct ScanMain2 { v4u qa[2][2], p[2], vtp[2]; };
struct ScanLate2 { v4u kd[4], vt[2][4], gm[4]; };
#define GLD16S(dst, sbase, voff, off) asm volatile("global_load_dwordx4 %0, %1, %2 offset:" #off : "=v"(dst) : "v"(voff), "s"(sbase) : "memory")
__device__ __forceinline__ void scan2_issue_main(ScanMain2& o, const bf16* QA, const bf16* VT, const bf16* SC, int b, int h, int sp, int n, int w, unsigned lo16) {
    const size_t item = ((size_t)b * NCHUNK + n) * GH + h;
    const bf16* q0 = QA + ((item * 8 + w) * 4) * 512;
    const bf16* v0 = VT + (((item * 16 + 2 * sp) * 4 + (w & 3)) * 64) * 8; const bf16* v1 = v0 + 2048;
    const bf16* p0 = SC + ((item * 4 + (w & 3)) * 2) * 512;
    GLD16S(o.qa[0][0], q0, lo16, 0); GLD16S(o.qa[0][1], q0, lo16, 1024); GLD16S(o.qa[1][0], q0, lo16, 2048); GLD16S(o.qa[1][1], q0, lo16, 3072);
    GLD16S(o.p[0], p0, lo16, 0); GLD16S(o.p[1], p0, lo16, 1024); GLD16S(o.vtp[0], v0, lo16, 0); GLD16S(o.vtp[1], v1, lo16, 0);
}
__device__ __forceinline__ void scan2_issue_late(ScanLate2& o, const bf16* KDT, const bf16* VT, const float* GAM, int b, int h, int sp, int n, int w, unsigned lo16, unsigned go16) {
    const size_t item = ((size_t)b * NCHUNK + n) * GH + h;
    const bf16* kp = KDT + ((item * 8 + w) * 4) * 512;
    const bf16* v0 = VT + (((item * 16 + 2 * sp) * 4) * 64) * 8; const bf16* v1 = v0 + 2048;
    const float* gp = GAM + item * HK + 32 * w;
    GLD16S(o.kd[0], kp, lo16, 0); GLD16S(o.kd[1], kp, lo16, 1024); GLD16S(o.kd[2], kp, lo16, 2048); GLD16S(o.kd[3], kp, lo16, 3072);
    GLD16S(o.vt[0][0], v0, lo16, 0); GLD16S(o.vt[0][1], v0, lo16, 1024); GLD16S(o.vt[0][2], v0, lo16, 2048); GLD16S(o.vt[0][3], v0, lo16, 3072);
    GLD16S(o.vt[1][0], v1, lo16, 0); GLD16S(o.vt[1][1], v1, lo16, 1024); GLD16S(o.vt[1][2], v1, lo16, 2048); GLD16S(o.vt[1][3], v1, lo16, 3072);
    GLD16S(o.gm[0], gp, go16, 0); GLD16S(o.gm[1], gp, go16, 32); GLD16S(o.gm[2], gp, go16, 64); GLD16S(o.gm[3], gp, go16, 96);
}
#define SCAN2_MAIN_REGS(o) "+v"(o.qa[0][0]), "+v"(o.qa[0][1]), "+v"(o.qa[1][0]), "+v"(o.qa[1][1]), "+v"(o.p[0]), "+v"(o.p[1]), "+v"(o.vtp[0]), "+v"(o.vtp[1])
#define SCAN2_LATE_REGS(o) "+v"(o.kd[0]), "+v"(o.kd[1]), "+v"(o.kd[2]), "+v"(o.kd[3]), "+v"(o.vt[0][0]), "+v"(o.vt[0][1]), "+v"(o.vt[0][2]), "+v"(o.vt[0][3]), \
    "+v"(o.vt[1][0]), "+v"(o.vt[1][1]), "+v"(o.vt[1][2]), "+v"(o.vt[1][3]), "+v"(o.gm[0]), "+v"(o.gm[1]), "+v"(o.gm[2]), "+v"(o.gm[3])
#define SCAN2_WAIT_MAIN(o) asm volatile("s_waitcnt vmcnt(24)" : SCAN2_MAIN_REGS(o) :: "memory")
#define SCAN2_WAIT_LATE(o) asm volatile("s_waitcnt vmcnt(8)" : SCAN2_LATE_REGS(o) :: "memory")
#define SCAN2_DRAIN_MAIN(o) asm volatile("s_waitcnt vmcnt(0)" : SCAN2_MAIN_REGS(o) :: "memory")
#define SCAN2_DRAIN_LATE(o) asm volatile("s_waitcnt vmcnt(0)" : SCAN2_LATE_REGS(o) :: "memory")
__device__ __forceinline__ void scan2_out(const v4u (&qa)[2][2], const v4u (&p)[2], const v4u& vtp, const f32x16& S, LAS float* buf, int w, int r, int hh) {
    f32x16 op[2];
#pragma unroll
    for (int mt = 0; mt < 2; ++mt)
#pragma unroll
        for (int i = 0; i < 16; ++i) op[mt][i] = 0.f;
    if (w < 4) {
#pragma unroll
        for (int mt = 0; mt < 2; ++mt) op[mt] = __builtin_amdgcn_mfma_f32_32x32x16_bf16(__builtin_bit_cast(s16x8, p[mt]), __builtin_bit_cast(s16x8, vtp), op[mt], 0, 0, 0); }
    const s16x8 sb0 = __builtin_bit_cast(s16x8, (v4u){cvtpk(S[0], S[1]), cvtpk(S[2], S[3]), cvtpk(S[4], S[5]), cvtpk(S[6], S[7])});
    const s16x8 sb1 = __builtin_bit_cast(s16x8, (v4u){cvtpk(S[8], S[9]), cvtpk(S[10], S[11]), cvtpk(S[12], S[13]), cvtpk(S[14], S[15])});
#pragma unroll
    for (int mt = 0; mt < 2; ++mt) { op[mt] = __builtin_amdgcn_mfma_f32_32x32x16_bf16(__builtin_bit_cast(s16x8, qa[mt][0]), sb0, op[mt], 0, 0, 0);
        op[mt] = __builtin_amdgcn_mfma_f32_32x32x16_bf16(__builtin_bit_cast(s16x8, qa[mt][1]), sb1, op[mt], 0, 0, 0); }
#pragma unroll
    for (int mt = 0; mt < 2; ++mt)
#pragma unroll
        for (int i = 0; i < 16; ++i) buf[w * 2048 + (32 * mt + crow32(i, hh)) * 32 + r] = op[mt][i];
}
__device__ __forceinline__ void scan2_state(const v4u (&kd)[4], const v4u (&vt)[4], const v4u (&gm)[4], f32x16& S) {
#pragma unroll
    for (int i = 0; i < 16; ++i) S[i] *= __uint_as_float(gm[i >> 2][i & 3]);
#pragma unroll
    for (int kk = 0; kk < 4; ++kk) S = __builtin_amdgcn_mfma_f32_32x32x16_bf16(__builtin_bit_cast(s16x8, kd[kk]), __builtin_bit_cast(s16x8, vt[kk]), S, 0, 0, 0);
}
#define SCAN2_BAR() do { asm volatile("s_waitcnt lgkmcnt(0)" ::: "memory"); __builtin_amdgcn_s_barrier(); asm volatile("" ::: "memory"); } while (0)
__device__ __forceinline__ void gla_scan2(Frame& F, int unit, const bf16* QA, const bf16* KDT, const bf16* VT, const bf16* SC, const float* GAM, float* OG) {
    LAS float* RB = (LAS float*)(F.lds);
    const int tid = F.tid, lane = F.lane, w = F.wave, r = lane & 31, hh = lane >> 5;
    const int bh = (unit & 7) * 2 + (unit >> 6), sp = (unit >> 3) & 7, b = bh >> 2, h = bh & 3;
    const unsigned lo16 = (unsigned)lane * 16u, go16 = (unsigned)(lane >> 5) * 16u;
    f32x16 S0, S1;
#pragma unroll
    for (int i = 0; i < 16; ++i) { S0[i] = 0.f; S1[i] = 0.f; }
    ScanMain2 A, B; ScanLate2 L;
    VM_WAIT();
    scan2_issue_main(A, QA, VT, SC, b, h, sp, 0, w, lo16);
    scan2_issue_late(L, KDT, VT, GAM, b, h, sp, 0, w, lo16, go16);
#pragma unroll 1
    for (int n = 0; n < NCHUNK; n += 2) {
        scan2_issue_main(B, QA, VT, SC, b, h, sp, n + 1, w, lo16);
        SCAN2_WAIT_MAIN(A);
        scan2_out(A.qa, A.p, A.vtp[0], S0, RB, w, r, hh); asm volatile("" ::: "memory"); scan2_out(A.qa, A.p, A.vtp[1], S1, RB + 16384, w, r, hh);
        SCAN2_WAIT_LATE(L);
        scan2_state(L.kd, L.vt[0], L.gm, S0); scan2_state(L.kd, L.vt[1], L.gm, S1);
        scan2_issue_late(L, KDT, VT, GAM, b, h, sp, n + 1, w, lo16, go16);
        SCAN2_BAR();
        scan_reduce(RB, OG, b * SEQ + n * CHUNK, h, 2 * sp, tid); asm volatile("" ::: "memory"); scan_reduce(RB + 16384, OG, b * SEQ + n * CHUNK, h, 2 * sp + 1, tid);
        SCAN2_BAR();
        scan2_issue_main(A, QA, VT, SC, b, h, sp, (n + 2 < NCHUNK) ? n + 2 : n, w, lo16);
        SCAN2_WAIT_MAIN(B);
        scan2_out(B.qa, B.p, B.vtp[0], S0, RB, w, r, hh); asm volatile("" ::: "memory"); scan2_out(B.qa, B.p, B.vtp[1], S1, RB + 16384, w, r, hh);
        SCAN2_WAIT_LATE(L);
        scan2_state(L.kd, L.vt[0], L.gm, S0); scan2_state(L.kd, L.vt[1], L.gm, S1);
        scan2_issue_late(L, KDT, VT, GAM, b, h, sp, (n + 2 < NCHUNK) ? n + 2 : n, w, lo16, go16);
        SCAN2_BAR();
        scan_reduce(RB, OG, b * SEQ + (n + 1) * CHUNK, h, 2 * sp, tid); asm volatile("" ::: "memory"); scan_reduce(RB + 16384, OG, b * SEQ + (n + 1) * CHUNK, h, 2 * sp + 1, tid);
        SCAN2_BAR();
    }
    SCAN2_DRAIN_MAIN(A); SCAN2_DRAIN_MAIN(B); SCAN2_DRAIN_LATE(L);
    __syncthreads();
}
__device__ __forceinline__ void gla_post(Frame& F, const float* OG, const bf16* PROJ, const float* gng, bf16* OP) {
    const int gw = F.vcu * NWAVES + F.wave, NGW = F.G * NWAVES;
    const f32x4 g0 = *(const f32x4*)(gng + 8 * F.lane), g1 = *(const f32x4*)(gng + 8 * F.lane + 4);
    for (int task = gw; task < M * GH; task += NGW) { const int t = task / GH, h = task % GH;
        const float* op = OG + (size_t)t * DGV + h * HV + 8 * F.lane;
        const f32x4 a = *(const f32x4*)op, c = *(const f32x4*)(op + 4);
        const float ss = (a.x * a.x + a.y * a.y) + (a.z * a.z + a.w * a.w) + (c.x * c.x + c.y * c.y) + (c.z * c.z + c.w * c.w);
        const float rstd = 1.0f / sqrtf(wave_sum(ss) * (1.0f / HV) + EPS);
        const v4u rv = *(const v4u*)(PROJ + (size_t)t * LDP + PC_R + h * HV + 8 * F.lane);
        const float r[8] = {bflo(rv.x), bfhi(rv.x), bflo(rv.y), bfhi(rv.y), bflo(rv.z), bfhi(rv.z), bflo(rv.w), bfhi(rv.w)};
        float o[8] = {a.x * rstd * g0.x, a.y * rstd * g0.y, a.z * rstd * g0.z, a.w * rstd * g0.w, c.x * rstd * g1.x, c.y * rstd * g1.y, c.z * rstd * g1.z, c.w * rstd * g1.w};
#pragma unroll
        for (int e = 0; e < 8; ++e) o[e] *= pg8::silu_f(r[e]);
        v4u w; w.x = pk2(o[0], o[1]); w.y = pk2(o[2], o[3]); w.z = pk2(o[4], o[5]); w.w = pk2(o[6], o[7]);
        *(v4u*)(OP + (size_t)t * (DCONV + DGV) + DCONV + h * HV + 8 * F.lane) = w; }
}

__device__ __forceinline__ void alow_phase(Frame& F, const bf16* XB, const bf16* WA, const float* SSQ, float* AL32) {
    LAS float* red = (LAS float*)(F.lds);
    const int lane = F.lane, r16 = lane & 15, q4 = lane >> 4, w = F.wave, rb = w & 1, kq = w >> 1;
    for (int vb = blockIdx.x; vb < M / 32; vb += F.G) {
        const bf16* ap = XB + (size_t)(32 * vb + 16 * rb + r16) * DM + 1024 * kq + 8 * q4;
        const bf16* bp = WA + (size_t)r16 * DM + 1024 * kq + 8 * q4;
        f32x4 acc = (f32x4){0.f, 0.f, 0.f, 0.f};
#pragma unroll 8
        for (int kk = 0; kk < 32; ++kk) { const s16x8 av = __builtin_bit_cast(s16x8, *(const v4u*)(ap + 32 * kk)), bv = __builtin_bit_cast(s16x8, *(const v4u*)(bp + 32 * kk));
            acc = __builtin_amdgcn_mfma_f32_16x16x32_bf16(av, bv, acc, 0, 0, 0); }
#pragma unroll
        for (int reg = 0; reg < 4; ++reg) red[w * 256 + (4 * q4 + reg) * 16 + r16] = acc[reg];
        __syncthreads();
        { const int t = F.tid, row32 = t >> 4, j = t & 15, rbb = row32 >> 4, i = row32 & 15;
          const float s = (red[(rbb + 0) * 256 + i * 16 + j] + red[(rbb + 2) * 256 + i * 16 + j]) + (red[(rbb + 4) * 256 + i * 16 + j] + red[(rbb + 6) * 256 + i * 16 + j]);
          const f32x4 p = *(const f32x4*)(SSQ + (size_t)(32 * vb + row32) * 64 + 4 * j); float ss = (p.x + p.y) + (p.z + p.w);
          ss += __shfl_xor(ss, 1); ss += __shfl_xor(ss, 2); ss += __shfl_xor(ss, 4); ss += __shfl_xor(ss, 8);
          AL32[(size_t)(32 * vb + row32) * 16 + j] = s * (1.0f / sqrtf(ss * (1.0f / DM) + EPS)); }
        __syncthreads();
    }
}

struct Args { const float* in[21]; float* out; unsigned char* ws; int ph_lo, ph_hi; };
__global__ void __launch_bounds__(NWAVES * 64, 2) fwd(Args args) {
    extern __shared__ __attribute__((aligned(16))) unsigned char lds[];
    Frame F;
    F.lds = (LAS unsigned char*)lds;
    F.MISC = (volatile LAS unsigned*)(F.lds + MISC_OFF);
    F.tid = threadIdx.x; F.lane = F.tid & 63; F.wave = __builtin_amdgcn_readfirstlane(F.tid >> 6);
    F.G = gridDim.x; { const int bx = blockIdx.x; F.vcu = (F.G % 8 == 0) ? (bx % 8) * (F.G / 8) + bx / 8 : bx; }
    unsigned char* ws = args.ws;
    F.ctl = (gu32*)(ws + WS_CTL);
    for (int u = F.tid; u < 64; u += NWAVES * 64) ((LAS unsigned*)(F.lds + MISC_OFF))[u] = 0u;
    __syncthreads();
    const int lo = args.ph_lo, hi = args.ph_hi;
    XcdBarrier bar; bar.bar = (unsigned*)(F.ctl + CW_BAR); bar.x = 0; bar.st = nullptr;
    if (hi - lo > 1) bar = xcd_barrier_post((unsigned*)(F.ctl + CW_BAR), F.MISC + 8);
#define IN(k) (lo <= (k) && (k) < hi)
#define SEAM(k) do { if (IN(k) && IN((k) + 1)) xcd_barrier(bar); } while (0)

    const float* x = args.in[0]; float* out = args.out;
    const bool scanc = SCAN_SPLIT && F.G == 256;
    const bool tailc = TAIL_CONV && F.G > TAIL_W0;
    bf16* Wgu1 = (bf16*)(ws + WS_WGU1); bf16* Wd1 = (bf16*)(ws + WS_WD1); bf16* Win = (bf16*)(ws + WS_WIN); bf16* Wco = (bf16*)(ws + WS_WCO);
    bf16* Wmo = (bf16*)(ws + WS_WMO); bf16* Wgu2 = (bf16*)(ws + WS_WGU2); bf16* Wd2 = (bf16*)(ws + WS_WD2);
    bf16* H = (bf16*)(ws + WS_H); bf16* ACT = (bf16*)(ws + WS_ACT); bf16* PROJ = (bf16*)(ws + WS_ACT);
    bf16* SC = (bf16*)(ws + WS_SC); float* OG = (float*)(ws + WS_OG); bf16* OP = (bf16*)(ws + WS_OP); bf16* CA = (bf16*)(ws + WS_OP);
    bf16* MG = (bf16*)(ws + WS_MG);
    bf16* QA = (bf16*)(ws + WS_QA); bf16* KDT = (bf16*)(ws + WS_KDT); bf16* VT = (bf16*)(ws + WS_VT); float* GAM = (float*)(ws + WS_GAM);
    float* SSQ = (float*)(ws + WS_SSQ); float* AL32 = (float*)(ws + WS_AL); bf16* WA = (bf16*)(ws + WS_WA);

    if (IN(0)) {
        LAS float* scr = (LAS float*)(F.lds + F.wave * 16640);
        conv_seg(F, args.in[2], DFF, DM, 0, DFF / 64, 64, 64, Wgu1, 1, 256, 0, scr);
        conv_seg(F, args.in[3], DFF, DM, 0, DFF / 64, 64, 64, Wgu1, 1, 256, 128, scr);
        conv_seg(F, args.in[4], DM, DFF, 0, DM / 64, 64, 64, Wd1, 0, 64, 0, scr);
        conv_seg(F, args.in[6], DIN_SRC, DM, 0, 12288 / 64, 64, 64, Win, 0, 64, 0, scr);
        conv_seg(F, args.in[6], DIN_SRC, DM, 12304, 8192 / 64, 64, 64, Win, 0, 64, PC_GA, scr);
        conv_seg(F, args.in[6], DIN_SRC, DM, 12288, 1, 16, 16, WA, 0, 64, 0, scr);
        if (!tailc) {
        conv_seg(F, args.in[9], DM, DCONV, 0, DM / 64, 64, 64, Wco, 0, 64, 0, scr, nullptr, -1, 0, DCONV + DGV, 0);
        conv_seg(F, args.in[13], DM, DGV, 0, DM / 64, 64, 64, Wco, 0, 64, 0, scr, nullptr, -1, 0, DCONV + DGV, DCONV);
        conv_seg(F, args.in[15], DM, DM, 0, DM / 64, 64, 64, Wmo, 0, 64, 0, scr); }
        if (!scanc) conv_seg(F, args.in[17], DFF, DM, 0, DFF / 64, 64, 64, Wgu2, 1, 256, 0, scr);
        conv_seg(F, args.in[18], DFF, DM, scanc ? SCAN_UP_BLK * 64 : 0, DFF / 64 - (scanc ? SCAN_UP_BLK : 0), 64, 64, Wgu2, 1, 256, 128 + (scanc ? (SCAN_UP_BLK >> 1) * 256 : 0), scr);
        if (!tailc) conv_seg(F, args.in[19], DM, DFF, 0, DM / 64, 64, 64, Wd2, 0, 64, 0, scr);
        rms_rows_bf16(F, x, args.in[1], H);
    }
    SEAM(0);
    if (IN(1)) { pg8::Gemm g{H, Wgu1, M, 2 * DFF, DM}; pg8::StaticOrder S; S.init(M, 2 * DFF, F.G, (int)blockIdx.x);
        pg8::EpiSwiGLU E{ACT, DFF};
        pg8::gemm_phase<pg8::EpiSwiGLU, pg8::StaticOrder, false, true>(F.lds + RING_OFF, g, S, E);
        if (tailc && (int)blockIdx.x >= TAIL_W0) {
            LAS float* scr = (LAS float*)(F.lds + F.wave * 16640); const int gw = ((int)blockIdx.x - TAIL_W0) * NWAVES + F.wave, ngw = (F.G - TAIL_W0) * NWAVES;
            conv_seg_pipe(F, args.in[9], DM, DCONV, 0, DM / 64, 64, 64, Wco, 0, 64, 0, scr, nullptr, gw, ngw, DCONV + DGV, 0);
            conv_seg_pipe(F, args.in[13], DM, DGV, 0, DM / 64, 64, 64, Wco, 0, 64, 0, scr, nullptr, gw, ngw, DCONV + DGV, DCONV);
            conv_seg_pipe(F, args.in[15], DM, DM, 0, DM / 64, 64, 64, Wmo, 0, 64, 0, scr, nullptr, gw, ngw);
            } }
    SEAM(1);
    if (IN(2)) { pg8::Gemm g{ACT, Wd1, M, DM, DFF}; pg8::StaticOrder S; S.init(M, DM, F.G, (int)blockIdx.x);
        pg8::EpiResidStats E{x, out, DM, 0.5f, H, SSQ, args.in[5]};
        pg8::gemm_phase<pg8::EpiResidStats, pg8::StaticOrder, true, true>(F.lds + RING_OFF, g, S, E); }
    SEAM(2);
    if (IN(3)) { pg8::Gemm g{H, Win, M, LDP, DM}; pg8::RstdOrder S; S.init(M, LDP, F.G, (int)blockIdx.x); S.init_r(SSQ, (LAS float*)(F.lds + RTAB_OFF), 1.0f / DM, EPS);
        pg8::EpiBf16R E{PROJ, LDP, &S};
        pg8::gemm_phase<pg8::EpiBf16R, pg8::RstdOrder, false, true>(F.lds + RING_OFF, g, S, E);
        alow_phase(F, H, WA, SSQ, AL32); }
    SEAM(3);
    if (IN(4)) { vt_transpose(F, PROJ, VT); __syncthreads(); gla_prep(F, PROJ, AL32, args.in[10], args.in[11], SC, QA, KDT, GAM); conv_branch(F, PROJ, args.in[7], args.in[8], CA); }
    SEAM(4);
    if (IN(5)) {
        if (scanc) {
            if ((int)blockIdx.x < 128) gla_scan2(F, (int)blockIdx.x, QA, KDT, VT, SC, GAM, OG);
            else { LAS float* scr = (LAS float*)(F.lds + F.wave * 16640); const int gw = ((int)blockIdx.x - 128) * NWAVES + F.wave, ngw = 128 * NWAVES;
                conv_seg_pipe(F, args.in[17], DFF, DM, 0, DFF / 64, 64, 64, Wgu2, 1, 256, 0, scr, nullptr, gw, ngw);
                if (SCAN_UP_BLK) conv_seg_pipe(F, args.in[18], DFF, DM, 0, SCAN_UP_BLK, 64, 64, Wgu2, 1, 256, 128, scr, nullptr, gw, ngw); }
        } else gla_scan(F, QA, KDT, VT, SC, GAM, OG);
    }
    SEAM(5);
    if (IN(6)) gla_post(F, OG, PROJ, args.in[12], OP);
    SEAM(6);
    if (IN(7)) { pg8::Gemm g{OP, Wco, M, DM, DCONV + DGV}; pg8::StaticOrder S; S.init(M, DM, F.G, (int)blockIdx.x);
        pg8::EpiGateMerge E{PROJ + PC_GA, PROJ + PC_GB, LDP, args.in[14], DM, MG, DM};
        pg8::gemm_phase<pg8::EpiGateMerge, pg8::StaticOrder, true, true>(F.lds + RING_OFF, g, S, E); }
    SEAM(7);
    if (IN(8)) { pg8::Gemm g{MG, Wmo, M, DM, DM}; pg8::StaticOrder S; S.init(M, DM, F.G, (int)blockIdx.x);
        pg8::EpiResidStats E{out, out, DM, 1.0f, H, SSQ, args.in[16]};
        pg8::gemm_phase<pg8::EpiResidStats, pg8::StaticOrder, true, true>(F.lds + RING_OFF, g, S, E); }
    SEAM(8);
    if (IN(9)) { pg8::Gemm g{H, Wgu2, M, 2 * DFF, DM}; pg8::RstdOrder S; S.init(M, 2 * DFF, F.G, (int)blockIdx.x); S.init_r(SSQ, (LAS float*)(F.lds + RTAB_OFF), 1.0f / DM, EPS);
        pg8::EpiSwiGLUR E{ACT, DFF, &S};
        pg8::gemm_phase<pg8::EpiSwiGLUR, pg8::RstdOrder, false, true>(F.lds + RING_OFF, g, S, E);
        if (tailc && (int)blockIdx.x >= TAIL_W0) {
            LAS float* scr = (LAS float*)(F.lds + F.wave * 16640); const int gw = ((int)blockIdx.x - TAIL_W0) * NWAVES + F.wave, ngw = (F.G - TAIL_W0) * NWAVES;
            conv_seg_pipe(F, args.in[19], DM, DFF, 0, DM / 64, 64, 64, Wd2, 0, 64, 0, scr, nullptr, gw, ngw); } }
    SEAM(9);
    if (IN(10)) { pg8::Gemm g{ACT, Wd2, M, DM, DFF}; pg8::StaticOrder S; S.init(M, DM, F.G, (int)blockIdx.x);
        pg8::EpiResidBf16 E{out, H, DM, 0.5f};
        pg8::gemm_phase<pg8::EpiResidBf16, pg8::StaticOrder, true, true>(F.lds + RING_OFF, g, S, E); }
    SEAM(10);
    if (IN(11)) rms_rows_final(F, H, out, args.in[20]);
#undef IN
#undef SEAM
}

#ifndef N_LAUNCH_MODE
#define N_LAUNCH_MODE 1
#endif
extern "C" void kernel_launch(void* const* d_in, const int* in_sizes, int n_in, void* d_out, int out_size, void* d_ws, size_t ws_size, hipStream_t stream) {
    static int grid = 0;
    if (grid == 0) {
        if (n_in != 21 || in_sizes[0] != M * DM || out_size != M * DM || ws_size < WS_END) { fprintf(stderr, "kernel_launch: unexpected problem (n_in %d, in0 %d, out %d, ws %zu < %zu)\n", n_in, n_in > 0 ? in_sizes[0] : -1, out_size, ws_size, (size_t)WS_END); grid = -1; return; }
        int dev = 0, cus = 0;
        if (hipGetDevice(&dev) != hipSuccess || hipDeviceGetAttribute(&cus, hipDeviceAttributeMultiprocessorCount, dev) != hipSuccess) { grid = -1; return; }
        if (hipFuncSetAttribute((const void*)fwd, hipFuncAttributeMaxDynamicSharedMemorySize, LDS_BYTES) != hipSuccess) { fprintf(stderr, "kernel_launch: hipFuncSetAttribute failed\n"); grid = -1; return; }
        (void)hipGetLastError();
        grid = cus;
    }
    if (grid < 0) return;
    if (hipMemsetAsync((char*)d_ws + WS_CTL, 0, CTL_ZERO_BYTES, stream) != hipSuccess) return;
    Args a{};
    for (int i = 0; i < 21; ++i) a.in[i] = (const float*)d_in[i];
    a.out = (float*)d_out; a.ws = (unsigned char*)d_ws;
    if (N_LAUNCH_MODE == 1) { a.ph_lo = 0; a.ph_hi = NPHASE; hipLaunchKernelGGL(fwd, dim3(grid), dim3(NWAVES * 64), LDS_BYTES, stream, a); }
    else for (int p = 0; p < NPHASE; ++p) { a.ph_lo = p; a.ph_hi = p + 1; hipLaunchKernelGGL(fwd, dim3(grid), dim3(NWAVES * 64), LDS_BYTES, stream, a); }
}
```
